# Optimizing an MI355X kernel written in HIP

```python
import math
import jax, jax.numpy as jnp
from jax import lax
import numpy as np

D_MODEL = 1024
BATCH = 8
SEQ = 4096
DEPTH = 4

A_HEADS = 8
A_HEAD_DIM = 64
A_WIDTH = A_HEADS * A_HEAD_DIM
IDX_HEADS = 8
IDX_DIM = 32
TOPK_MAX = 256
DSA_BLOCK = 64
S5_WIDTH = 512
S5_GROUP = 16
S5_GROUPS = S5_WIDTH // S5_GROUP
S5_STATE = 64
DT_MIN = 0.001
DT_MAX = 0.1
GLA_HEADS = 4
GLA_DK = 64
GLA_DV = 128
GLA_QK = GLA_HEADS * GLA_DK
GLA_VW = GLA_HEADS * GLA_DV
GLA_RANK = 16
GLA_TAU = 16.0
GLA_CHUNK = 64
N_BRANCH = 3
BRANCH_WIDTH = 512
D_FF = 2816
CONV_W = 3
EPS = 1e-6

IN_SPLITS = (A_WIDTH, A_WIDTH, A_WIDTH,
             IDX_HEADS * IDX_DIM, IDX_DIM, IDX_HEADS,
             S5_WIDTH,
             GLA_QK, GLA_QK, GLA_VW, GLA_VW,
             GLA_RANK,
             N_BRANCH * D_MODEL)
D_IN = sum(IN_SPLITS)

kernel_name = 'hybrid_gated_dsa_s5_gla_trunk'


def rmsnorm(x, g):
    xf = x.astype(jnp.float32)
    y = xf * lax.rsqrt(jnp.mean(xf * xf, axis=-1, keepdims=True) + EPS)
    return (y * g.astype(jnp.float32)).astype(x.dtype)


def adaln(c, w, b):
    m = jax.nn.silu(c) @ w + b
    shift, scale, gate = jnp.split(m[:, None, :], 3, axis=-1)
    return shift, scale, gate


def dsa_attention(q, k, v, qi, ki, wi):
    B, T = q.shape[0], q.shape[1]
    K = min(TOPK_MAX, T // 4)
    nb = T // DSA_BLOCK

    def blocks(a):
        return a.reshape((B, nb, DSA_BLOCK) + a.shape[2:]).swapaxes(0, 1)

    starts = jnp.arange(nb, dtype=jnp.int32) * DSA_BLOCK
    kif = ki.astype(jnp.float32)
    key_pos = jnp.arange(T, dtype=jnp.int32)
    gather = jax.vmap(lambda a, i: a[i])

    def one_block(args):
        qb, qib, wb, t0 = args
        t = t0 + jnp.arange(DSA_BLOCK, dtype=jnp.int32)
        dots = jnp.einsum('bqhd,bsd->bqhs', qib.astype(jnp.float32), kif)
        score = jnp.einsum('bqh,bqhs->bqs', wb.astype(jnp.float32), jax.nn.relu(dots))
        causal = key_pos[None, :] <= t[:, None]
        score = jnp.where(causal[None], score, -jnp.inf)
        _, idx = lax.top_k(score, K)
        valid = idx <= t[None, :, None]
        kg = gather(k, idx)
        vg = gather(v, idx)
        logits = jnp.einsum('bqhd,bqkhd->bqhk', qb, kg,
                            preferred_element_type=jnp.float32) * (A_HEAD_DIM ** -0.5)
        logits = jnp.where(valid[:, :, None, :], logits, -jnp.inf)
        p = jax.nn.softmax(logits, axis=-1).astype(v.dtype)
        return jnp.einsum('bqhk,bqkhd->bqhd', p, vg)

    out = lax.map(one_block, (blocks(q), blocks(qi), blocks(wi), starts))
    return out.swapaxes(0, 1).reshape(B, T, A_WIDTH)


def s5_mixer(u, lam_re, lam_im, log_dt, b_re, b_im, c_re, c_im, d_skip, w_glu):
    B, T = u.shape[0], u.shape[1]
    f32 = jnp.float32
    dt = jnp.exp(log_dt.astype(f32))[:, None]
    lr, li = lam_re.astype(f32), lam_im.astype(f32)
    mag = jnp.exp(lr * dt)
    ab_re, ab_im = mag * jnp.cos(li * dt), mag * jnp.sin(li * dt)
    den = lr * lr + li * li
    nr, ni = ab_re - 1.0, ab_im
    f_re = (nr * lr + ni * li) / den
    f_im = (ni * lr - nr * li) / den
    br, bi = b_re.astype(f32), b_im.astype(f32)
    bb_re = f_re[..., None] * br - f_im[..., None] * bi
    bb_im = f_re[..., None] * bi + f_im[..., None] * br
    ug = u.astype(f32).reshape(B, T, S5_GROUPS, S5_GROUP)
    bu_re = jnp.einsum('gnp,btgp->btgn', bb_re, ug)
    bu_im = jnp.einsum('gnp,btgp->btgn', bb_im, ug)
    a_re = jnp.broadcast_to(ab_re, bu_re.shape)
    a_im = jnp.broadcast_to(ab_im, bu_im.shape)

    def combine(e1, e2):
        a1r, a1i, b1r, b1i = e1
        a2r, a2i, b2r, b2i = e2
        return (a2r * a1r - a2i * a1i,
                a2r * a1i + a2i * a1r,
                a2r * b1r - a2i * b1i + b2r,
                a2r * b1i + a2i * b1r + b2i)

    _, _, x_re, x_im = lax.associative_scan(combine, (a_re, a_im, bu_re, bu_im), axis=1)
    y = (jnp.einsum('gpn,btgn->btgp', c_re.astype(f32), x_re)
         - jnp.einsum('gpn,btgn->btgp', c_im.astype(f32), x_im))
    y = y.reshape(B, T, S5_WIDTH) + d_skip.astype(f32) * u.astype(f32)
    g = jax.nn.gelu(y).astype(u.dtype)
    ga, gb = jnp.split(g @ w_glu, 2, axis=-1)
    return ga * jax.nn.sigmoid(gb)


def gla_mixer(q, k, v, r, lr_feat, w_gate, b_gate, norm_g):
    B, T = q.shape[0], q.shape[1]
    f32 = jnp.float32
    C = GLA_CHUNK
    nc = T // C

    def chunks(a, d):
        return a.reshape(B, nc, C, GLA_HEADS, d).transpose(0, 3, 1, 2, 4)

    log_a = jax.nn.log_sigmoid((lr_feat @ w_gate + b_gate).astype(f32)) / GLA_TAU
    qc = chunks(q.astype(f32), GLA_DK) * (GLA_DK ** -0.5)
    kc = chunks(k.astype(f32), GLA_DK)
    vc = chunks(v.astype(f32), GLA_DV)
    cum = jnp.cumsum(chunks(log_a, GLA_DK), axis=3)
    last = cum[:, :, :, -1:, :]
    q_dec = qc * jnp.exp(cum)
    k_inv = kc * jnp.exp(-cum)
    k_tail = kc * jnp.exp(last - cum)
    tri = jnp.tril(jnp.ones((C, C), dtype=bool))
    att = jnp.where(tri, jnp.einsum('bhncd,bhnsd->bhncs', q_dec, k_inv), 0.0)
    o_intra = jnp.einsum('bhncs,bhnse->bhnce', att, vc)
    kv_chunk = jnp.einsum('bhnsd,bhnse->bhnde', k_tail, vc)
    decay = jnp.exp(last[:, :, :, 0, :])

    def step(S, inp):
        dec, kv = inp
        return dec[..., None] * S + kv, S

    S0 = jnp.zeros((B, GLA_HEADS, GLA_DK, GLA_DV), f32)
    _, S_prev = lax.scan(step, S0, (jnp.moveaxis(decay, 2, 0), jnp.moveaxis(kv_chunk, 2, 0)))
    S_prev = jnp.moveaxis(S_prev, 0, 2)
    o_inter = jnp.einsum('bhncd,bhnde->bhnce', q_dec, S_prev)
    o = (o_intra + o_inter).transpose(0, 2, 3, 1, 4).reshape(B, T, GLA_HEADS, GLA_DV)
    o = rmsnorm(o, norm_g).reshape(B, T, GLA_VW).astype(q.dtype)
    return o * jax.nn.silu(r)


def token_mixing(h, w_in, s5_lam_re, s5_lam_im, s5_log_dt, s5_b_re, s5_b_im, s5_c_re, s5_c_im,
                 s5_d, s5_w_glu, gla_w_gate, gla_b_gate, gla_norm_g, w_branch, w_out):
    B, T = h.shape[0], h.shape[1]
    proj = h @ w_in
    split_at = [int(i) for i in np.cumsum(IN_SPLITS)[:-1]]
    aq, ak, av, iq, ik, iw, s5u, gq, gk, gv, gr, glr, gl = jnp.split(proj, split_at, axis=-1)
    y_a = dsa_attention(aq.reshape(B, T, A_HEADS, A_HEAD_DIM),
                        ak.reshape(B, T, A_HEADS, A_HEAD_DIM),
                        av.reshape(B, T, A_HEADS, A_HEAD_DIM),
                        iq.reshape(B, T, IDX_HEADS, IDX_DIM), ik,
                        iw * ((IDX_HEADS * IDX_DIM) ** -0.5))
    y_b = s5_mixer(s5u, s5_lam_re, s5_lam_im, s5_log_dt, s5_b_re, s5_b_im, s5_c_re, s5_c_im,
                   s5_d, s5_w_glu)
    y_c = gla_mixer(gq, gk, gv, gr, glr, gla_w_gate, gla_b_gate, gla_norm_g)
    ys = jnp.stack([y_a, y_b.astype(h.dtype), y_c], axis=2)
    branch = jnp.einsum('btie,ied->btid', ys, w_branch)
    gate = jax.nn.sigmoid(gl.reshape(B, T, N_BRANCH, D_MODEL).astype(jnp.float32)).astype(h.dtype)
    merged = jnp.sum(gate * branch, axis=2)
    return merged @ w_out


def causal_dwconv(x, w, b):
    T = x.shape[1]
    xp = jnp.pad(x, ((0, 0), (CONV_W - 1, 0), (0, 0)))
    return sum(w[j] * xp[:, j:j + T] for j in range(CONV_W)) + b


def conv_ffn(h, w_up, conv_w, conv_b, w_down):
    u = causal_dwconv(h @ w_up, conv_w, conv_b)
    g, val = jnp.split(u, 2, axis=-1)
    return (jax.nn.gelu(g, approximate=True) * val) @ w_down


def setup_inputs(seed: int = 0) -> dict:
    key = jax.random.key(seed)
    ks = iter(jax.random.split(key, 32))
    f32 = jnp.float32

    def nrm(shape, scale):
        return jax.random.normal(next(ks), shape, f32) * scale

    L, D = DEPTH, D_MODEL
    n_idx = jnp.arange(S5_STATE, dtype=f32)
    return {
        'x': nrm((BATCH, SEQ, D), 1.0),
        'c': nrm((BATCH, D), 1.0),
        'mix_mod_w': nrm((L, D, 3 * D), D ** -0.5),
        'mix_mod_b': nrm((L, 3 * D), 0.01),
        'mix_pre_g': 1.0 + nrm((L, D), 0.02),
        'mix_post_g': 1.0 + nrm((L, D), 0.02),
        'w_in': nrm((L, D, D_IN), D ** -0.5),
        's5_lam_re': -0.5 + nrm((L, S5_GROUPS, S5_STATE), 0.01),
        's5_lam_im': jnp.pi * n_idx + nrm((L, S5_GROUPS, S5_STATE), 0.01),
        's5_log_dt': jax.random.uniform(next(ks), (L, S5_GROUPS), f32,
                                        math.log(DT_MIN), math.log(DT_MAX)),
        's5_b_re': nrm((L, S5_GROUPS, S5_STATE, S5_GROUP), (2.0 * S5_GROUP) ** -0.5),
        's5_b_im': nrm((L, S5_GROUPS, S5_STATE, S5_GROUP), (2.0 * S5_GROUP) ** -0.5),
        's5_c_re': nrm((L, S5_GROUPS, S5_GROUP, S5_STATE), (2.0 * S5_STATE) ** -0.5),
        's5_c_im': nrm((L, S5_GROUPS, S5_GROUP, S5_STATE), (2.0 * S5_STATE) ** -0.5),
        's5_d': nrm((L, S5_WIDTH), 1.0),
        's5_w_glu': nrm((L, S5_WIDTH, 2 * S5_WIDTH), S5_WIDTH ** -0.5),
        'gla_w_gate': nrm((L, GLA_RANK, GLA_QK), GLA_RANK ** -0.5),
        'gla_b_gate': nrm((L, GLA_QK), 0.01),
        'gla_norm_g': 1.0 + nrm((L, GLA_HEADS, GLA_DV), 0.02),
        'w_branch': nrm((L, N_BRANCH, BRANCH_WIDTH, D), BRANCH_WIDTH ** -0.5),
        'w_out': nrm((L, D, D), D ** -0.5),
        'ffn_mod_w': nrm((L, D, 3 * D), D ** -0.5),
        'ffn_mod_b': nrm((L, 3 * D), 0.01),
        'ffn_pre_g': 1.0 + nrm((L, D), 0.02),
        'ffn_post_g': 1.0 + nrm((L, D), 0.02),
        'ffn_w_up': nrm((L, D, 2 * D_FF), D ** -0.5),
        'ffn_conv_w': nrm((L, CONV_W, 2 * D_FF), CONV_W ** -0.5),
        'ffn_conv_b': nrm((L, 2 * D_FF), 0.01),
        'ffn_w_down': nrm((L, D_FF, D), D_FF ** -0.5),
    }


def reference(x, c, mix_mod_w, mix_mod_b, mix_pre_g, mix_post_g, w_in,
              s5_lam_re, s5_lam_im, s5_log_dt, s5_b_re, s5_b_im, s5_c_re, s5_c_im, s5_d, s5_w_glu,
              gla_w_gate, gla_b_gate, gla_norm_g, w_branch, w_out,
              ffn_mod_w, ffn_mod_b, ffn_pre_g, ffn_post_g, ffn_w_up, ffn_conv_w, ffn_conv_b,
              ffn_w_down):
    for l in range(DEPTH):
        shift, scale, gate = adaln(c, mix_mod_w[l], mix_mod_b[l])
        h = rmsnorm(x, mix_pre_g[l]) * (1.0 + scale) + shift
        y = token_mixing(h, w_in[l], s5_lam_re[l], s5_lam_im[l], s5_log_dt[l], s5_b_re[l],
                         s5_b_im[l], s5_c_re[l], s5_c_im[l], s5_d[l], s5_w_glu[l],
                         gla_w_gate[l], gla_b_gate[l], gla_norm_g[l], w_branch[l], w_out[l])
        x = x + gate * rmsnorm(y, mix_post_g[l])
        shift, scale, gate = adaln(c, ffn_mod_w[l], ffn_mod_b[l])
        h = rmsnorm(x, ffn_pre_g[l]) * (1.0 + scale) + shift
        y = conv_ffn(h, ffn_w_up[l], ffn_conv_w[l], ffn_conv_b[l], ffn_w_down[l])
        x = x + gate * rmsnorm(y, ffn_post_g[l])
    return x
```

```cpp
#include <hip/hip_runtime.h>
#include <cstdio>
#include <cstdint>

#ifndef MK_ONE_LAUNCH
#define MK_ONE_LAUNCH 1
#endif
#define DBG_TOL 1e-4f
#ifndef PHSEL_MASK
#define PHSEL_MASK 0xFFFFFFFFu
#endif
#define PHSEL(k) (((PHSEL_MASK) >> (k)) & 1u)
#ifndef IDX_SPLIT
#define IDX_SPLIT 0
#endif
#ifndef DSA_TERMS
#define DSA_TERMS 1
#endif
#ifndef DUP_MASK
#define DUP_MASK 0u
#endif
#define NREP(k) ((((DUP_MASK) >> (k)) & 1u) ? 2 : 1)

#define LAS __attribute__((address_space(3)))
#define GAS __attribute__((address_space(1)))
typedef unsigned short bf16_t;
typedef short bf16x8 __attribute__((ext_vector_type(8)));
typedef short bf16x4 __attribute__((ext_vector_type(4)));
typedef float f32x2 __attribute__((ext_vector_type(2)));
typedef float f32x4 __attribute__((ext_vector_type(4)));
typedef float f32x16 __attribute__((ext_vector_type(16)));
typedef unsigned u32x2 __attribute__((ext_vector_type(2)));
typedef unsigned u32x4 __attribute__((ext_vector_type(4)));
typedef __bf16 bf16x2v __attribute__((ext_vector_type(2)));
typedef _Float16 f16x2 __attribute__((ext_vector_type(2)));
typedef _Float16 f16x8 __attribute__((ext_vector_type(8)));

constexpr int D = 1024, BATCH = 8, T = 4096, DEPTH = 4;
constexpr int MH = 4 * T;
constexpr int NB_H = 4;
constexpr int D_IN = 6968, NPROJ = 7168;
constexpr int DFF = 2816, DUP = 2 * DFF;
constexpr int S5L = 32, S5NC = T / S5L;
constexpr int S5K = 640;
constexpr int GC = 64, GNC = T / GC;
constexpr float EPS = 1e-6f;

constexpr size_t al256(size_t x) { return (x + 255) & ~(size_t)255; }
constexpr size_t MiB = 1u << 20;
constexpr size_t WS_CTL = 0, CTL_BYTES = 1 * MiB;
constexpr size_t WS_MOD = WS_CTL + CTL_BYTES;
constexpr size_t WS_WIN = WS_MOD + al256((size_t)4 * 2 * 8 * 3072 * 4);
constexpr size_t WS_WGLU = WS_WIN + (size_t)NPROJ * D * 2;
constexpr size_t WS_WBR = WS_WGLU + (size_t)1024 * 512 * 2;
constexpr size_t WS_WOUT = WS_WBR + (size_t)3072 * 512 * 2;
constexpr size_t WS_WUP = WS_WOUT + (size_t)D * D * 2;
constexpr size_t WS_WDN = WS_WUP + (size_t)DUP * D * 2;
constexpr size_t WS_S5BO = WS_WDN + (size_t)D * DFF * 2;
constexpr size_t WS_S5BS = WS_S5BO + (size_t)32 * 512 * S5K * 2;
constexpr size_t WS_WINLO = WS_S5BS + (size_t)32 * 256 * 512 * 2;
constexpr size_t WS_REG = WS_WINLO + (size_t)512 * D * 2;
constexpr size_t R_H = 0;
constexpr size_t R_HLO = R_H + (size_t)MH * D * 2;
constexpr size_t R_AQ = R_HLO + (size_t)MH * D * 2;
constexpr size_t R_AK = R_AQ + (size_t)MH * 512 * 2;
constexpr size_t R_AVT = R_AK + (size_t)MH * 512 * 2;
constexpr size_t R_IQH = R_AVT + (size_t)MH * 512 * 2;
constexpr size_t R_IQL = R_IQH + (size_t)MH * 256 * 2;
constexpr size_t R_IKH = R_IQL + (size_t)MH * 256 * 2;
constexpr size_t R_IKL = R_IKH + (size_t)MH * 32 * 2;
constexpr size_t R_IW = R_IKL + (size_t)MH * 32 * 2;
constexpr size_t R_GQ = R_IW + (size_t)MH * 8 * 4;
constexpr size_t R_GK = R_GQ + (size_t)MH * 256 * 2;
constexpr size_t R_GV = R_GK + (size_t)MH * 256 * 2;
constexpr size_t R_GR = R_GV + (size_t)MH * 512 * 2;
constexpr size_t R_GLR = R_GR + (size_t)MH * 512 * 2;
constexpr size_t R_GATES = R_GLR + (size_t)MH * 16 * 4;
constexpr size_t R_YS = R_GATES + (size_t)3 * MH * D * 2;
constexpr size_t R_S5A = R_YS + (size_t)3 * MH * 512 * 2;
constexpr size_t R_S5SC = R_S5A + (size_t)32 * 512 * S5K * 2;
constexpr size_t R_GACT = R_S5SC + (size_t)32 * 512 * 128 * 4;
constexpr size_t R_QD = R_HLO;
constexpr size_t R_KI = R_QD + (size_t)MH * 256 * 2;
constexpr size_t R_VT = R_KI + (size_t)MH * 256 * 2;
static_assert(R_VT + (size_t)MH * 512 * 2 <= R_AQ, "GLA copies fit over h_lo");
constexpr size_t R_KVT = R_GACT + (size_t)MH * 512 * 2;
constexpr size_t R_ST = R_KVT + (size_t)4 * 4 * 64 * 128 * 64 * 4;
constexpr size_t R_DEC = R_ST + (size_t)4 * 4 * 64 * 128 * 64 * 2;
constexpr size_t R_MASK = R_DEC + (size_t)4 * 64 * 256 * 4;
constexpr size_t R_MIX_END = R_MASK + (size_t)4 * 128 * 128 * 64 * 4;
constexpr size_t R_Y = R_AQ;
constexpr size_t R_HF = 0;
constexpr size_t R_U = R_HF + (size_t)MH * D * 2;
constexpr size_t R_ACT = R_U + (size_t)MH * DUP * 2;
constexpr size_t R_Y2 = R_ACT + (size_t)MH * DFF * 2;
constexpr size_t R_FFN_END = R_Y2 + (size_t)MH * D * 2;
constexpr size_t WS_END = WS_REG + (R_MIX_END > R_FFN_END ? R_MIX_END : R_FFN_END);
static_assert(WS_END <= (size_t)512 * MiB, "workspace map exceeds 512 MiB");
static_assert(R_Y + (size_t)MH * D * 2 <= R_AVT, "y overlay");

constexpr int CW_BAR = 4096;
constexpr int CW_DSAQ = 2048;
constexpr int CW_C3Q = 2112;

constexpr int LDS_BYTES = 163840;
constexpr int MISC_OFF = LDS_BYTES - 256;

__device__ __forceinline__ float bf2f(unsigned b) { return __uint_as_float(b << 16); }
__device__ __forceinline__ unsigned pk2b(float lo, float hi) { f32x2 v = {lo, hi}; bf16x2v b = __builtin_convertvector(v, bf16x2v); return __builtin_bit_cast(unsigned, b); }
__device__ __forceinline__ unsigned pk2(float lo, float hi) { f32x2 v = {lo, hi}; f16x2 b = __builtin_convertvector(v, f16x2); return __builtin_bit_cast(unsigned, b); }
__device__ __forceinline__ float hlo(unsigned w) { const f16x2 h = __builtin_bit_cast(f16x2, w); return (float)h[0]; }
__device__ __forceinline__ float hhi(unsigned w) { const f16x2 h = __builtin_bit_cast(f16x2, w); return (float)h[1]; }
__device__ __forceinline__ float h2f(unsigned short b) { return (float)__builtin_bit_cast(_Float16, b); }
__device__ __forceinline__ unsigned short f2h(float f) { return __builtin_bit_cast(unsigned short, (_Float16)f); }
__device__ __forceinline__ unsigned short f2b(float f) { return (unsigned short)(pk2b(f, 0.f) & 0xffffu); }
__device__ __forceinline__ float bflo(unsigned w) { return __uint_as_float(w << 16); }
__device__ __forceinline__ float bfhi(unsigned w) { return __uint_as_float(w & 0xffff0000u); }
__device__ __forceinline__ float wave_sum(float v) {
#pragma unroll
    for (int o = 1; o < 64; o <<= 1) v += __shfl_xor(v, o);
    return v;
}
__device__ __forceinline__ float sigmoidf_(float x) { return __builtin_amdgcn_rcpf(1.0f + __expf(-x)); }
__device__ __forceinline__ float gelu_tanh(float x) { const float u = 1.5957691216057308f * (x + 0.044715f * x * x * x); return x * __builtin_amdgcn_rcpf(1.0f + __expf(-u)); }
#define OPAQUE_GPTR(p) do { GAS unsigned char* _g = (GAS unsigned char*)(p); asm volatile("" : "+s"(_g)); (p) = (decltype(p))_g; } while (0)
#define VM_WAIT() asm volatile("s_waitcnt vmcnt(0)" ::: "memory")
#define LDS_WAIT() asm volatile("s_waitcnt lgkmcnt(0)" ::: "memory")

#define XB_TMO      128
#define XB_XCNT(j)  (256  + 64 * (j))
#define XB_XSUB(j)  (1280 + 64 * (j))
#define XB_XGEN(j)  (2304 + 64 * (j))
#define XB_TOP      3328
#define XB_TOPGEN   3392
#define XCD_BAR_WORDS 3456
#define XB_SPIN_CAP (1u << 18)
__device__ __forceinline__ unsigned xb_ld(unsigned* p)              { return __hip_atomic_load(p, __ATOMIC_RELAXED, __HIP_MEMORY_SCOPE_AGENT); }
__device__ __forceinline__ unsigned xb_add(unsigned* p, unsigned v) { return __hip_atomic_fetch_add(p, v, __ATOMIC_RELAXED, __HIP_MEMORY_SCOPE_AGENT); }
__device__ __forceinline__ unsigned xb_xcc_id() { return (unsigned)__builtin_amdgcn_s_getreg((3 << 11) | 20) & 0xFu; }
#define XB_SPIN(cond, bar) do { unsigned _sp = 0; while (cond) { __builtin_amdgcn_s_sleep(1); \
    if ((++_sp & 255u) == 0u) { if (xb_ld(&(bar)[XB_TMO])) break; if (_sp > XB_SPIN_CAP) { atomicAdd(&(bar)[XB_TMO], 1u); break; } } } } while (0)
struct XcdBarrier { unsigned* bar; unsigned x; volatile LAS unsigned* st; };
__device__ __forceinline__ XcdBarrier xcd_barrier_post(unsigned* bar, volatile LAS unsigned* st) {
    XcdBarrier b; b.bar = bar; b.x = xb_xcc_id(); b.st = st;
    if (threadIdx.x == 0) (void)xb_add(&bar[XB_XCNT(b.x)], 1u);
    return b;
}
__device__ __forceinline__ void xcd_barrier_complete(unsigned* bar, unsigned x, unsigned& nloc, unsigned& nx) {
    const unsigned G = gridDim.x * gridDim.y * gridDim.z;
    unsigned sum, cnt, mine, sp = 0u;
    for (;;) {
        sum = 0u; cnt = 0u; mine = 0u;
#pragma unroll
        for (unsigned j = 0; j < 16; ++j) { const unsigned c = xb_ld(&bar[XB_XCNT(j)]); sum += c; cnt += (c > 0u) ? 1u : 0u; mine = (j == x) ? c : mine; }
        if (sum == G) break;
        __builtin_amdgcn_s_sleep(1);
        if ((++sp & 255u) == 0u) { if (xb_ld(&bar[XB_TMO])) break; if (sp > XB_SPIN_CAP) { atomicAdd(&bar[XB_TMO], 1u); break; } }
    }
    nloc = mine > 0u ? mine : 1u; nx = cnt > 0u ? cnt : 1u;
}
__device__ __forceinline__ void xcd_barrier(const XcdBarrier& b) {
    asm volatile("s_waitcnt vmcnt(0)" ::: "memory");
    __syncthreads();
    if (threadIdx.x == 0) {
        unsigned* bar = b.bar;
        __builtin_amdgcn_s_waitcnt(0);
        unsigned nloc = b.st[0], nx = b.st[1];
        if (nloc == 0u) { xcd_barrier_complete(bar, b.x, nloc, nx); b.st[0] = nloc; b.st[1] = nx; }
        const unsigned old = xb_add(&bar[XB_XSUB(b.x)], 1u);
        const unsigned gen = old / nloc;
        if (old + 1u == (gen + 1u) * nloc) {
            __builtin_amdgcn_fence(__ATOMIC_RELEASE, "agent");
            asm volatile("s_waitcnt vmcnt(0)" ::: "memory");
            const unsigned og = xb_add(&bar[XB_TOP], 1u);
            const unsigned tg = og / nx;
            if (og + 1u == (tg + 1u) * nx) xb_add(&bar[XB_TOPGEN], 1u);
            else XB_SPIN(xb_ld(&bar[XB_TOPGEN]) == tg, bar);
            __builtin_amdgcn_fence(__ATOMIC_ACQUIRE, "agent");
            xb_add(&bar[XB_XGEN(b.x)], 1u);
            asm volatile("s_waitcnt vmcnt(0)" ::: "memory");
        } else {
            XB_SPIN(xb_ld(&bar[XB_XGEN(b.x)]) == gen, bar);
            __builtin_amdgcn_fence(__ATOMIC_ACQUIRE, "agent");
            asm volatile("s_waitcnt vmcnt(0)" ::: "memory");
        }
    }
    __syncthreads();
}

namespace pg8 {
constexpr int BM = 256, BK = 64, HALF = 128, HTB = HALF * BK * 2, STAGE_BYTES = 8 * HTB, NXCD = 8, WGM = 8;
__host__ __device__ __forceinline__ int lds_byte(int r, int c) { const int st = (r >> 4) * 2 + (c >> 5), rr = r & 15, cc = c & 31, ob = rr * 64 + cc * 2; return st * 1024 + (ob ^ (((ob >> 9) & 1) << 5)); }
__host__ __device__ __forceinline__ void stage_rc(int b, int& R, int& C) { const int st = b / 1024, sb = b % 1024, swz = sb ^ (((sb >> 9) & 1) << 5); R = (st >> 1) * 16 + swz / 64; C = (st & 1) * 32 + (swz % 64) / 2; }
__host__ __device__ __forceinline__ int perm32(int rho) { const int n = rho >> 4, i = rho & 15; return 8 * (i >> 2) + 4 * n + (i & 3); }

struct Unit { int pm, pn, sub, g; size_t aoff, boff; };
struct Gemm { const bf16_t* A; const bf16_t* Bt; int lda, ldb, K; };

struct SchedGrid {
    int nM, nN, nwg, G, c, nMh; size_t astep, bstep, ahalf;
    __device__ void init(int nM_, int nN_, int G_, int c_, size_t astep_, size_t bstep_) { nM = nM_; nN = nN_; nwg = nM * nN; G = G_; c = c_; astep = astep_; bstep = bstep_; nMh = 0; ahalf = 0; }
    __device__ __forceinline__ bool next(int i, Unit& u) const {
        const long L = (long)i * G + c; if (L >= nwg) return false;
        int wgid = (int)L; { const int q = nwg / NXCD, r = nwg % NXCD, xcd = wgid % NXCD, off = wgid / NXCD; wgid = (xcd < r ? xcd * (q + 1) : r * (q + 1) + (xcd - r) * q) + off; }
        const int nig = WGM * nN, gid = wgid / nig, fm = gid * WGM, gsz = (nM - fm) < WGM ? (nM - fm) : WGM;
        u.pm = fm + ((wgid % nig) % gsz); u.pn = (wgid % nig) / gsz; u.sub = 0; u.g = 0;
        u.aoff = nMh ? (size_t)(u.pm % nMh) * astep + (size_t)(u.pm / nMh) * ahalf : (size_t)u.pm * astep; u.boff = (size_t)u.pn * bstep; return true;
    }
};
struct SchedProj {
    int G, c; size_t alo, blo;
    __device__ bool next(int i, Unit& u) const {
        const int ni = c < 128 ? (128 - c + G - 1) / G : 0;
        if (i < 3 * ni) { const int k = i / 3, sub = i - 3 * k, t = c + k * G; u.pm = t >> 1; u.pn = 6 + (t & 1); u.sub = sub; u.g = 0;
            u.aoff = (size_t)u.pm * 256 * D * 2 + (sub == 1 ? alo : (size_t)0); u.boff = sub == 2 ? blo + (size_t)(t & 1) * 256 * D * 2 : (size_t)u.pn * 256 * D * 2; return true; }
        const int j = i - 3 * ni; int r;
        if (G == 256) { if (c < 128) { if (j >= 5) return false; r = c * 5 + j; } else { if (j >= 8) return false; r = 640 + (c - 128) * 8 + j; } }
        else { r = c + j * G; if (r >= 1664) return false; }
        const int pm = r / 26, k = r - pm * 26; u.pm = pm; u.pn = k < 6 ? k : k + 2; u.sub = 0; u.g = 0; u.aoff = (size_t)pm * 256 * D * 2; u.boff = (size_t)u.pn * 256 * D * 2; return true;
    }
};
struct SchedMerge {
    SchedGrid S; size_t abr, bbr;
    __device__ bool next(int i, Unit& u) const {
        const int round = i / 3, sub = i - round * 3;
        if (!S.next(round, u)) return false;
        u.sub = sub; u.aoff += (size_t)sub * abr; u.boff += (size_t)sub * bbr; return true;
    }
};
struct SchedS5 {
    int G, c, npn;
    __device__ bool next(int i, Unit& u) const {
        const int L = i * G + c; const int per_g = 2 * npn; if (L >= 32 * per_g) return false;
        const int g = L / per_g, r = L - g * per_g; u.g = g; u.pm = r / npn; u.pn = r - u.pm * npn; u.sub = 0;
        u.aoff = ((size_t)g * 512 + (size_t)u.pm * 256) * S5K * 2;
        u.boff = npn == 1 ? (size_t)g * 256 * 512 * 2 : ((size_t)g * 512 + (size_t)u.pn * 256) * S5K * 2;
        return true;
    }
};

#ifndef PG8_SP2
#define PG8_SP2 true
#endif
#ifndef PG8_ALIGN
#define PG8_ALIGN true
#endif
template <class Epi, class Sched, bool ALIGN_EPI = PG8_ALIGN, bool SP2 = PG8_SP2>
__device__ __forceinline__ void gemm_phase(LAS unsigned char* lds, const Gemm g, const Sched& S, const Epi& E) {
    int tid = threadIdx.x; asm volatile("" : "+v"(tid));
    const int wid = __builtin_amdgcn_readfirstlane(tid >> 6), lane = tid & 63, wr = wid >> 2, wc = wid & 3, fr = lane & 15, fq = lane >> 4;
    const int K = g.K, nt = K / BK;
    const char* gA = (const char*)g.A; const char* gB = (const char*)g.Bt;
    OPAQUE_GPTR(gA); OPAQUE_GPTR(gB);
    unsigned voffA[2], voffB[2];
#pragma unroll
    for (int i = 0; i < 2; ++i) { int R, C; stage_rc(tid * 16 + i * 8192, R, C); const int Rb = (R & ~31) + perm32(R & 31);
        voffA[i] = (unsigned)(R * g.lda + C) * 2u; voffB[i] = (unsigned)(Rb * g.ldb + C) * 2u; }
    const size_t kstep = (size_t)(BK * 2);
    const size_t hstepA = (size_t)HALF * g.lda * 2, hstepB = (size_t)HALF * g.ldb * 2;
    const unsigned ldsw = (unsigned)wid * 1024u;
    const int aoff = lds_byte(wr * 64 + fr, fq * 8), boff = lds_byte(wc * 32 + fr, fq * 8);
#define PG8_SA(b, h) (((b) * 2 + (h)) * HTB)
#define PG8_SB(b, h) ((4 + (b) * 2 + (h)) * HTB)
#define PG8_STAGE(bufoff, gbase, voff) do { _Pragma("unroll") for (int _i = 0; _i < 2; ++_i) \
        __builtin_amdgcn_global_load_lds((const unsigned*)((const char*)(gbase) + (voff)[_i]), (LAS unsigned*)(lds + (bufoff) + ldsw + _i * 8192), 16, 0, 0); } while (0)
#define PG8_LDA(dst, b, h) do { _Pragma("unroll") for (int m = 0; m < 4; ++m) _Pragma("unroll") for (int k = 0; k < 2; ++k) dst[m][k] = *(const LAS bf16x8*)(lds + PG8_SA(b, h) + aoff + m * 2048 + k * 1024); } while (0)
#define PG8_LDB(dst, b, h) do { _Pragma("unroll") for (int n = 0; n < 2; ++n) _Pragma("unroll") for (int k = 0; k < 2; ++k) dst[n][k] = *(const LAS bf16x8*)(lds + PG8_SB(b, h) + boff + n * 2048 + k * 1024); } while (0)
#define PG8_MMA(ai, bj, At, Bt) do { __builtin_amdgcn_s_setprio(1); _Pragma("unroll") for (int m = 0; m < 4; ++m) _Pragma("unroll") for (int n = 0; n < 2; ++n) _Pragma("unroll") for (int k = 0; k < 2; ++k) \
        acc[ai][bj][m][n] = __builtin_amdgcn_mfma_f32_16x16x32_f16(__builtin_bit_cast(f16x8, Bt[n][k]), __builtin_bit_cast(f16x8, At[m][k]), acc[ai][bj][m][n], 0, 0, 0); __builtin_amdgcn_s_setprio(0); } while (0)
#define PG8_WAIT_V(n) asm volatile("s_waitcnt vmcnt(" #n ")" ::: "memory")
#define PG8_WAIT_L(n) asm volatile("s_waitcnt lgkmcnt(" #n ")" ::: "memory")
#define PG8_BAR __builtin_amdgcn_s_barrier()
#define PG8_SCHED __builtin_amdgcn_sched_barrier(0)
    Unit cur, nxt; int ui = 0;
    if (!S.next(0, cur)) return;
    f32x4 acc[2][2][4][2];
#pragma unroll
    for (int a = 0; a < 2; ++a)
#pragma unroll
        for (int b = 0; b < 2; ++b)
#pragma unroll
            for (int m = 0; m < 4; ++m)
#pragma unroll
                for (int n = 0; n < 2; ++n) acc[a][b][m][n] = (f32x4){0.f, 0.f, 0.f, 0.f};
    bf16x8 At[4][2], B0[2][2], B1[2][2];
    const char* cA = gA + cur.aoff; const char* cB = gB + cur.boff;
    if constexpr (SP2) {
        PG8_STAGE(PG8_SB(0, 0), cB, voffB); PG8_STAGE(PG8_SB(0, 1), cB + hstepB, voffB); PG8_STAGE(PG8_SA(0, 0), cA, voffA); PG8_STAGE(PG8_SA(0, 1), cA + hstepA, voffA);
        if (wr == 1) PG8_BAR;
        PG8_WAIT_V(2); PG8_BAR;
        PG8_STAGE(PG8_SB(1, 0), cB + kstep, voffB); PG8_STAGE(PG8_SA(1, 0), cA + kstep, voffA); PG8_STAGE(PG8_SB(1, 1), cB + hstepB + kstep, voffB);
        PG8_WAIT_V(6); PG8_BAR;
    } else {
        PG8_STAGE(PG8_SB(0, 0), cB, voffB); PG8_STAGE(PG8_SA(0, 0), cA, voffA); PG8_STAGE(PG8_SB(0, 1), cB + hstepB, voffB); PG8_STAGE(PG8_SA(0, 1), cA + hstepA, voffA);
        if (wr == 1) PG8_BAR;
        PG8_WAIT_V(4); PG8_BAR;
        PG8_STAGE(PG8_SB(1, 0), cB + kstep, voffB); PG8_STAGE(PG8_SA(1, 0), cA + kstep, voffA); PG8_STAGE(PG8_SB(1, 1), cB + hstepB + kstep, voffB);
        PG8_WAIT_V(6); PG8_BAR;
    }
    for (;;) {
        const bool has_next = S.next(ui + 1, nxt);
        const char* nA = has_next ? gA + nxt.aoff : cA; const char* nB = has_next ? gB + nxt.boff : cB;
        for (int t = 0; t < nt; t += 2) {
            const bool last = (t == nt - 2);
            const char* a1 = cA + (size_t)(t + 1) * kstep;
            const char* a2 = last ? nA : cA + (size_t)(t + 2) * kstep; const char* b2 = last ? nB : cB + (size_t)(t + 2) * kstep;
            const char* a3 = a2 + kstep; const char* b3 = b2 + kstep;
            if constexpr (SP2) {
            PG8_LDB(B0, 0, 0); PG8_LDB(B1, 0, 1); PG8_SCHED; PG8_LDA(At, 0, 0); PG8_STAGE(PG8_SA(1, 1), a1 + hstepA, voffA);
            PG8_WAIT_V(8); PG8_WAIT_L(0); PG8_BAR; PG8_MMA(0, 0, At, B0); PG8_MMA(0, 1, At, B1); PG8_BAR; PG8_SCHED;
            PG8_LDA(At, 0, 1); PG8_STAGE(PG8_SB(0, 0), b2, voffB); PG8_STAGE(PG8_SB(0, 1), b2 + hstepB, voffB); PG8_STAGE(PG8_SA(0, 0), a2, voffA);
            PG8_WAIT_V(8); PG8_WAIT_L(0); PG8_BAR; PG8_MMA(1, 0, At, B0); PG8_MMA(1, 1, At, B1); PG8_BAR; PG8_SCHED;
            PG8_LDB(B0, 1, 0); PG8_LDB(B1, 1, 1); PG8_SCHED; PG8_LDA(At, 1, 0); PG8_STAGE(PG8_SA(0, 1), a2 + hstepA, voffA);
            PG8_WAIT_V(8); PG8_WAIT_L(0); PG8_BAR; PG8_MMA(0, 0, At, B0); PG8_MMA(0, 1, At, B1); PG8_BAR; PG8_SCHED;
            PG8_LDA(At, 1, 1); PG8_STAGE(PG8_SB(1, 0), b3, voffB); PG8_STAGE(PG8_SB(1, 1), b3 + hstepB, voffB); PG8_STAGE(PG8_SA(1, 0), a3, voffA);
            PG8_WAIT_V(8); PG8_WAIT_L(0); PG8_BAR; PG8_MMA(1, 0, At, B0); PG8_MMA(1, 1, At, B1); PG8_BAR; PG8_SCHED;
            } else {
            PG8_LDB(B0, 0, 0); PG8_SCHED; PG8_LDA(At, 0, 0); PG8_STAGE(PG8_SA(1, 1), a1 + hstepA, voffA);
            PG8_WAIT_L(8); PG8_BAR; PG8_WAIT_L(0); PG8_MMA(0, 0, At, B0); PG8_BAR; PG8_SCHED;
            PG8_LDB(B1, 0, 1); PG8_STAGE(PG8_SB(0, 0), b2, voffB);
            PG8_BAR; PG8_WAIT_L(0); PG8_MMA(0, 1, At, B1); PG8_BAR;
            PG8_LDA(At, 0, 1); PG8_STAGE(PG8_SA(0, 0), a2, voffA);
            PG8_BAR; PG8_WAIT_L(0); PG8_MMA(1, 0, At, B0); PG8_BAR; PG8_SCHED;
            PG8_STAGE(PG8_SB(0, 1), b2 + hstepB, voffB);
            PG8_WAIT_V(6); PG8_BAR; PG8_MMA(1, 1, At, B1); PG8_BAR;
            PG8_LDB(B0, 1, 0); PG8_SCHED; PG8_LDA(At, 1, 0); PG8_STAGE(PG8_SA(0, 1), a2 + hstepA, voffA);
            PG8_WAIT_L(8); PG8_BAR; PG8_WAIT_L(0); PG8_MMA(0, 0, At, B0); PG8_BAR; PG8_SCHED;
            PG8_LDB(B1, 1, 1); PG8_STAGE(PG8_SB(1, 0), b3, voffB);
            PG8_BAR; PG8_WAIT_L(0); PG8_MMA(0, 1, At, B1); PG8_BAR;
            PG8_LDA(At, 1, 1); PG8_STAGE(PG8_SA(1, 0), a3, voffA);
            PG8_BAR; PG8_WAIT_L(0); PG8_MMA(1, 0, At, B0); PG8_BAR; PG8_SCHED;
            PG8_STAGE(PG8_SB(1, 1), b3 + hstepB, voffB);
            PG8_WAIT_V(6); PG8_BAR; PG8_MMA(1, 1, At, B1); PG8_BAR;
            }
        }
        if constexpr (ALIGN_EPI) { if (wr == 0) PG8_BAR; }
        const bool keep = E(acc, cur, wr, wc, fr, fq);
        if (!has_next) break;
        if (!keep) {
#pragma unroll
            for (int a = 0; a < 2; ++a)
#pragma unroll
                for (int b = 0; b < 2; ++b)
#pragma unroll
                    for (int m = 0; m < 4; ++m)
#pragma unroll
                        for (int n = 0; n < 2; ++n) acc[a][b][m][n] = (f32x4){0.f, 0.f, 0.f, 0.f};
        }
        cur = nxt; cA = nA; cB = nB; ++ui;
        if constexpr (ALIGN_EPI) { if (wr == 1) PG8_BAR; }
    }
    PG8_WAIT_V(0);
    if constexpr (!ALIGN_EPI) { if (wr == 0) PG8_BAR; }
    PG8_BAR;
#undef PG8_SA
#undef PG8_SB
#undef PG8_STAGE
#undef PG8_LDA
#undef PG8_LDB
#undef PG8_MMA
#undef PG8_WAIT_V
#undef PG8_WAIT_L
#undef PG8_BAR
#undef PG8_SCHED
}
}

using pg8::Unit;
typedef f32x4 AccT[2][2][4][2];
__host__ __device__ __forceinline__ size_t avt_index(size_t b, size_t hd, size_t t) { const size_t i = t & 31; return ((b * 8 + (hd >> 6)) * 128 + (t >> 5)) * 2048 + (hd & 63) * 32 + ((i & 0x13) | ((i & 4) << 1) | ((i & 8) >> 1)); }
__device__ __forceinline__ u32x4 pack8(const f32x4 a, const f32x4 b) { u32x4 w; w.x = pk2(a[0], a[1]); w.y = pk2(a[2], a[3]); w.z = pk2(b[0], b[1]); w.w = pk2(b[2], b[3]); return w; }

#ifndef ST_WT
#define ST_WT 1
#endif
__device__ __forceinline__ void st16(void* p, const u32x4 v) {
#if ST_WT
    asm volatile("global_store_dwordx4 %0, %1, off sc1\n\ts_nop 1" :: "v"(p), "v"(v) : "memory");
#else
    *(u32x4*)p = v;
#endif
}
__device__ __forceinline__ void store_tile_bf16(const AccT& acc, bf16_t* base, size_t ld, int wr, int wc, int fr, int fq) {
#pragma unroll
    for (int ai = 0; ai < 2; ++ai)
#pragma unroll
        for (int m = 0; m < 4; ++m) { bf16_t* rowp = base + (size_t)(ai * 128 + wr * 64 + m * 16 + fr) * ld + wc * 32 + fq * 8;
#pragma unroll
            for (int bj = 0; bj < 2; ++bj) st16(rowp + bj * 128, pack8(acc[ai][bj][m][0], acc[ai][bj][m][1])); }
}
struct EpiPlain {
    bf16_t* O; int ld;
    __device__ __forceinline__ bool operator()(AccT& acc, const Unit& u, int wr, int wc, int fr, int fq) const {
        asm volatile("" : "+v"(fr), "+v"(fq));
        bf16_t* Op = O; OPAQUE_GPTR(Op); store_tile_bf16(acc, Op + (size_t)u.pm * 256 * ld + (size_t)u.pn * 256, (size_t)ld, wr, wc, fr, fq); return false; }
};
__device__ __forceinline__ unsigned dpp_prev(unsigned cur, unsigned prev, int which  ) {
    if (which == 1) { const int o = __builtin_amdgcn_update_dpp(0, (int)prev, 0x121, 0xF, 0xF, true); return (unsigned)__builtin_amdgcn_update_dpp(o, (int)cur, 0x111, 0xF, 0xF, false); }
    const int o = __builtin_amdgcn_update_dpp(0, (int)prev, 0x122, 0xF, 0xF, true); return (unsigned)__builtin_amdgcn_update_dpp(o, (int)cur, 0x112, 0xF, 0xF, false);
}
struct EpiUpConv {
    const float* cw; const float* cb; bf16_t* ACT; bf16_t* EDGE; LAS unsigned* ex;
    __device__ __forceinline__ bool operator()(AccT& acc, const Unit& u, int wr, int wc, int fr, int fq) const {
        asm volatile("" : "+v"(fr), "+v"(fq));
        const int lc0 = wc * 32 + fq * 8;
        unsigned P[2][2][4][2][2];
#pragma unroll
        for (int ai = 0; ai < 2; ++ai)
#pragma unroll
            for (int bj = 0; bj < 2; ++bj)
#pragma unroll
                for (int m = 0; m < 4; ++m)
#pragma unroll
                    for (int n = 0; n < 2; ++n) { P[ai][bj][m][n][0] = pk2(acc[ai][bj][m][n][0], acc[ai][bj][m][n][1]); P[ai][bj][m][n][1] = pk2(acc[ai][bj][m][n][2], acc[ai][bj][m][n][3]); }
        if (fr >= 14) {
#pragma unroll
            for (int ai = 0; ai < 2; ++ai)
#pragma unroll
                for (int bj = 0; bj < 2; ++bj) { u32x4 w; w.x = P[ai][bj][3][0][0]; w.y = P[ai][bj][3][0][1]; w.z = P[ai][bj][3][1][0]; w.w = P[ai][bj][3][1][1];
                    *(LAS u32x4*)(ex + (((ai * 2 + wr) * 2 + (fr - 14)) * 2 + bj) * 64 + (lc0 >> 1)) = w; }
        }
        bf16_t* edge = EDGE + ((size_t)u.pm * 22 + u.pn) * 1024;
        if (wr == 0 && fr < 2) {
#pragma unroll
            for (int bj = 0; bj < 2; ++bj) { u32x4 w; w.x = P[0][bj][0][0][0]; w.y = P[0][bj][0][0][1]; w.z = P[0][bj][0][1][0]; w.w = P[0][bj][0][1][1]; *(u32x4*)(edge + fr * 256 + bj * 128 + lc0) = w; } }
        if (wr == 1 && fr >= 14) {
#pragma unroll
            for (int bj = 0; bj < 2; ++bj) { u32x4 w; w.x = P[1][bj][3][0][0]; w.y = P[1][bj][3][0][1]; w.z = P[1][bj][3][1][0]; w.w = P[1][bj][3][1][1]; *(u32x4*)(edge + 512 + (fr - 14) * 256 + bj * 128 + lc0) = w; } }
        __builtin_amdgcn_s_barrier();
        const float* cwp = cw; const float* cbp = cb; OPAQUE_GPTR(cwp); OPAQUE_GPTR(cbp);
        const int gcol0 = u.pn * 128 + lc0;
        f16x2 wg[2][3][2], wv[2][3][2], bgp[2][2], bvp[2][2];
#pragma unroll
        for (int n = 0; n < 2; ++n) { const int gc = gcol0 + 4 * n;
            const f32x4 g0 = *(const f32x4*)(cwp + gc), g1 = *(const f32x4*)(cwp + DUP + gc), g2 = *(const f32x4*)(cwp + 2 * DUP + gc), gb = *(const f32x4*)(cbp + gc);
            const f32x4 v0 = *(const f32x4*)(cwp + DFF + gc), v1 = *(const f32x4*)(cwp + DUP + DFF + gc), v2 = *(const f32x4*)(cwp + 2 * DUP + DFF + gc), vb = *(const f32x4*)(cbp + DFF + gc);
#pragma unroll
            for (int pr = 0; pr < 2; ++pr) { wg[n][0][pr] = __builtin_bit_cast(f16x2, pk2(g0[2 * pr], g0[2 * pr + 1])); wg[n][1][pr] = __builtin_bit_cast(f16x2, pk2(g1[2 * pr], g1[2 * pr + 1])); wg[n][2][pr] = __builtin_bit_cast(f16x2, pk2(g2[2 * pr], g2[2 * pr + 1]));
                bgp[n][pr] = __builtin_bit_cast(f16x2, pk2(gb[2 * pr], gb[2 * pr + 1])); wv[n][0][pr] = __builtin_bit_cast(f16x2, pk2(v0[2 * pr], v0[2 * pr + 1])); wv[n][1][pr] = __builtin_bit_cast(f16x2, pk2(v1[2 * pr], v1[2 * pr + 1]));
                wv[n][2][pr] = __builtin_bit_cast(f16x2, pk2(v2[2 * pr], v2[2 * pr + 1])); bvp[n][pr] = __builtin_bit_cast(f16x2, pk2(vb[2 * pr], vb[2 * pr + 1])); } }
#pragma unroll
        for (int ai = 0; ai < 2; ++ai) {
            const int blk = ai * 2 + wr;
            unsigned pg[2][2] = {{0u, 0u}, {0u, 0u}}, pv[2][2] = {{0u, 0u}, {0u, 0u}};
            if (blk > 0) { const u32x4 a = *(const LAS u32x4*)(ex + ((((blk - 1) * 2 + (fr & 1)) * 2 + 0) * 64) + (lc0 >> 1)), b = *(const LAS u32x4*)(ex + ((((blk - 1) * 2 + (fr & 1)) * 2 + 1) * 64) + (lc0 >> 1));
                pg[0][0] = a.x; pg[0][1] = a.y; pg[1][0] = a.z; pg[1][1] = a.w; pv[0][0] = b.x; pv[0][1] = b.y; pv[1][0] = b.z; pv[1][1] = b.w; }
#pragma unroll
            for (int m = 0; m < 4; ++m) { float o[8];
#pragma unroll
                for (int n = 0; n < 2; ++n)
#pragma unroll
                    for (int pr = 0; pr < 2; ++pr) { const unsigned cg = P[ai][0][m][n][pr], cv = P[ai][1][m][n][pr];
                        const unsigned xg1 = dpp_prev(cg, pg[n][pr], 1), xg2 = dpp_prev(cg, pg[n][pr], 2), xv1 = dpp_prev(cv, pv[n][pr], 1), xv2 = dpp_prev(cv, pv[n][pr], 2);
                        const int j = 4 * n + 2 * pr;
                        const f16x2 gq = wg[n][2][pr] * __builtin_bit_cast(f16x2, cg) + wg[n][1][pr] * __builtin_bit_cast(f16x2, xg1) + wg[n][0][pr] * __builtin_bit_cast(f16x2, xg2) + bgp[n][pr];
                        const f16x2 vq = wv[n][2][pr] * __builtin_bit_cast(f16x2, cv) + wv[n][1][pr] * __builtin_bit_cast(f16x2, xv1) + wv[n][0][pr] * __builtin_bit_cast(f16x2, xv2) + bvp[n][pr];
                        o[j] = gelu_tanh((float)gq[0]) * (float)vq[0]; o[j + 1] = gelu_tanh((float)gq[1]) * (float)vq[1]; pg[n][pr] = cg; pv[n][pr] = cv; }
                { u32x4 w; w.x = pk2(o[0], o[1]); w.y = pk2(o[2], o[3]); w.z = pk2(o[4], o[5]); w.w = pk2(o[6], o[7]); st16(ACT + ((size_t)u.pm * 256 + ai * 128 + wr * 64 + m * 16 + fr) * DFF + gcol0, w); }
                __builtin_amdgcn_sched_barrier(0);
            }
        }
        __builtin_amdgcn_s_barrier();
        return false;
    }
};
struct EpiProj {
    unsigned char* reg_;
    __device__ __forceinline__ bool operator()(AccT& acc, const Unit& u, int wr, int wc, int fr, int fq) const {
        asm volatile("" : "+v"(fr), "+v"(fq));
        unsigned char* reg = reg_; OPAQUE_GPTR(reg);
        const int pn = u.pn; const size_t r0 = (size_t)u.pm * 256;
        if (pn < 4) { bf16_t* O = (bf16_t*)(reg + (pn < 2 ? R_AQ : R_AK)); store_tile_bf16(acc, O + r0 * 512 + (size_t)(pn & 1) * 256, 512, wr, wc, fr, fq); }
        else if (pn < 6) {
            bf16_t* O = (bf16_t*)(reg + R_AVT);
#pragma unroll
            for (int ai = 0; ai < 2; ++ai)
#pragma unroll
                for (int m = 0; m < 4; ++m) { const size_t r = r0 + ai * 128 + wr * 64 + m * 16 + fr; const size_t b = r >> 12, t = r & 4095;
#pragma unroll
                    for (int bj = 0; bj < 2; ++bj) { const int hd0 = (pn - 4) * 256 + bj * 128 + wc * 32 + fq * 8;
#pragma unroll
                        for (int n = 0; n < 2; ++n)
#pragma unroll
                            for (int j = 0; j < 4; ++j) O[avt_index(b, hd0 + n * 4 + j, t)] = f2h(acc[ai][bj][m][n][j]); } }
        }
        else if (pn == 6) {
            if (IDX_SPLIT && u.sub < 2) return true;
#pragma unroll
            for (int ai = 0; ai < 2; ++ai)
#pragma unroll
                for (int m = 0; m < 4; ++m) { const size_t off = (r0 + ai * 128 + wr * 64 + m * 16 + fr) * 256 + wc * 32 + fq * 8;
#pragma unroll
                    for (int bj = 0; bj < 2; ++bj) { const f32x4 a = acc[ai][bj][m][0], b = acc[ai][bj][m][1]; const u32x4 hi = pack8(a, b);
                        const f32x4 al = {a[0] - hlo(hi.x), a[1] - hhi(hi.x), a[2] - hlo(hi.y), a[3] - hhi(hi.y)}, bl = {b[0] - hlo(hi.z), b[1] - hhi(hi.z), b[2] - hlo(hi.w), b[3] - hhi(hi.w)};
                        *(u32x4*)((bf16_t*)(reg + R_IQH) + off + bj * 128) = hi; if (IDX_SPLIT) *(u32x4*)((bf16_t*)(reg + R_IQL) + off + bj * 128) = pack8(al, bl); } }
        }
        else if (pn == 7) {
            if (IDX_SPLIT && u.sub < 2) return true;
            if (wc < 2) {
#pragma unroll
                for (int ai = 0; ai < 2; ++ai)
#pragma unroll
                    for (int m = 0; m < 4; ++m) { const size_t r = r0 + ai * 128 + wr * 64 + m * 16 + fr; const f32x4 a = acc[ai][0][m][0], b = acc[ai][0][m][1];
                        if (wc == 0) { const u32x4 hi = pack8(a, b);
                            const f32x4 al = {a[0] - hlo(hi.x), a[1] - hhi(hi.x), a[2] - hlo(hi.y), a[3] - hhi(hi.y)}, bl = {b[0] - hlo(hi.z), b[1] - hhi(hi.z), b[2] - hlo(hi.w), b[3] - hhi(hi.w)};
                            *(u32x4*)((bf16_t*)(reg + R_IKH) + r * 32 + fq * 8) = hi; if (IDX_SPLIT) *(u32x4*)((bf16_t*)(reg + R_IKL) + r * 32 + fq * 8) = pack8(al, bl); }
                        else if (fq == 0) { float* o = (float*)(reg + R_IW) + r * 8; *(f32x4*)o = a * 0.0625f; *(f32x4*)(o + 4) = b * 0.0625f; }
                        else if (fq < 3) { float* o = (float*)(reg + R_GLR) + r * 16 + (fq - 1) * 8; *(f32x4*)o = a; *(f32x4*)(o + 4) = b; } }
            }
        }
        else if (pn < 10) {
            bf16_t* O = (bf16_t*)(reg + R_S5A);
#pragma unroll
            for (int ai = 0; ai < 2; ++ai)
#pragma unroll
                for (int m = 0; m < 4; ++m) { const size_t r = r0 + ai * 128 + wr * 64 + m * 16 + fr; const size_t b = r >> 12, t = r & 4095, ch = t >> 5, j = t & 31;
#pragma unroll
                    for (int bj = 0; bj < 2; ++bj) { const int c = (pn - 8) * 256 + bj * 128 + wc * 32 + fq * 8; const size_t g = c >> 4, p = c & 15;
                        *(u32x4*)(O + ((g * 512 + b * 128 + ch) * S5K + j * 16 + p)) = pack8(acc[ai][bj][m][0], acc[ai][bj][m][1]); } }
        }
        else if (pn < 12) store_tile_bf16(acc, (bf16_t*)(reg + (pn == 10 ? R_GQ : R_GK)) + r0 * 256, 256, wr, wc, fr, fq);
        else if (pn < 16) { bf16_t* O = (bf16_t*)(reg + (pn < 14 ? R_GV : R_GR)); store_tile_bf16(acc, O + r0 * 512 + (size_t)(pn & 1) * 256, 512, wr, wc, fr, fq); }
        else {
            const int c0 = (pn - 16) * 256, br = c0 >> 10, d0 = c0 & 1023;
            bf16_t* O = (bf16_t*)(reg + R_GATES) + ((size_t)br * MH + r0) * D + d0;
#pragma unroll
            for (int ai = 0; ai < 2; ++ai)
#pragma unroll
                for (int m = 0; m < 4; ++m) { bf16_t* rowp = O + (size_t)(ai * 128 + wr * 64 + m * 16 + fr) * D + wc * 32 + fq * 8;
#pragma unroll
                    for (int bj = 0; bj < 2; ++bj) { f32x4 a = acc[ai][bj][m][0], b = acc[ai][bj][m][1];
#pragma unroll
                        for (int j = 0; j < 4; ++j) { a[j] = fmaxf(sigmoidf_(a[j]), 6.2e-5f); b[j] = fmaxf(sigmoidf_(b[j]), 6.2e-5f); }
#ifdef DBG_ZERO_BRANCH
                        if (br == DBG_ZERO_BRANCH) { a = (f32x4){6.2e-5f, 6.2e-5f, 6.2e-5f, 6.2e-5f}; b = a; }
#endif
                        *(u32x4*)(rowp + bj * 128) = pack8(a, b); } }
        }
        return false;
    }
};
struct EpiS5State {
    float* SC;
    __device__ __forceinline__ bool operator()(AccT& acc, const Unit& u, int wr, int wc, int fr, int fq) const {
        asm volatile("" : "+v"(fr), "+v"(fq));
#pragma unroll
        for (int ai = 0; ai < 2; ++ai)
#pragma unroll
            for (int m = 0; m < 4; ++m) { const size_t row = (size_t)u.pm * 256 + ai * 128 + wr * 64 + m * 16 + fr; float* o = SC + ((size_t)u.g * 512 + row) * 128 + wc * 32 + fq * 8;
                *(f32x4*)o = acc[ai][0][m][0]; *(f32x4*)(o + 4) = acc[ai][0][m][1]; }
        return false;
    }
};
struct EpiS5Out {
    const bf16_t* A; const float* dsk; bf16_t* GA;
    __device__ __forceinline__ bool operator()(AccT& acc, const Unit& u, int wr, int wc, int fr, int fq) const {
        asm volatile("" : "+v"(fr), "+v"(fq));
#pragma unroll
        for (int ai = 0; ai < 2; ++ai)
#pragma unroll
            for (int m = 0; m < 4; ++m) { const size_t row = (size_t)u.pm * 256 + ai * 128 + wr * 64 + m * 16 + fr; const size_t b = row >> 7, ch = row & 127;
#pragma unroll
                for (int bj = 0; bj < 2; ++bj) { const int col = u.pn * 256 + bj * 128 + wc * 32 + fq * 8; const int j = col >> 4, p = col & 15;
                    const u32x4 uu = *(const u32x4*)(A + (((size_t)u.g * 512 + row) * S5K + col));
                    const f32x4 d0 = *(const f32x4*)(dsk + u.g * 16 + p), d1 = *(const f32x4*)(dsk + u.g * 16 + p + 4);
                    f32x4 a = acc[ai][bj][m][0], c = acc[ai][bj][m][1];
                    a[0] += d0[0] * hlo(uu.x); a[1] += d0[1] * hhi(uu.x); a[2] += d0[2] * hlo(uu.y); a[3] += d0[3] * hhi(uu.y);
                    c[0] += d1[0] * hlo(uu.z); c[1] += d1[1] * hhi(uu.z); c[2] += d1[2] * hlo(uu.w); c[3] += d1[3] * hhi(uu.w);
#pragma unroll
                    for (int q = 0; q < 4; ++q) { a[q] = gelu_tanh(a[q]); c[q] = gelu_tanh(c[q]); }
                    *(u32x4*)(GA + ((b * 4096 + ch * 32 + j) * 512 + u.g * 16 + p)) = pack8(a, c); } }
        return false;
    }
};
struct EpiGlu {
    bf16_t* O;
    __device__ __forceinline__ bool operator()(AccT& acc, const Unit& u, int wr, int wc, int fr, int fq) const {
        asm volatile("" : "+v"(fr), "+v"(fq));
#pragma unroll
        for (int ai = 0; ai < 2; ++ai)
#pragma unroll
            for (int m = 0; m < 4; ++m) { const size_t row = (size_t)u.pm * 256 + ai * 128 + wr * 64 + m * 16 + fr;
                f32x4 a = acc[ai][0][m][0], c = acc[ai][0][m][1]; const f32x4 ga = acc[ai][1][m][0], gc = acc[ai][1][m][1];
#pragma unroll
                for (int q = 0; q < 4; ++q) { a[q] *= sigmoidf_(ga[q]); c[q] *= sigmoidf_(gc[q]); }
                *(u32x4*)(O + row * 512 + u.pn * 128 + wc * 32 + fq * 8) = pack8(a, c); }
        return false;
    }
};
struct EpiMerge {
    const bf16_t* GT; bf16_t* O;
    __device__ __forceinline__ bool operator()(AccT& acc, const Unit& u, int wr, int wc, int fr, int fq) const {
        asm volatile("" : "+v"(fr), "+v"(fq));
        const int sub = u.sub;
        const bf16_t* GTp = GT; OPAQUE_GPTR(GTp);
#pragma unroll
        for (int ai = 0; ai < 2; ++ai) {
            u32x4 G0[4][2], G1[4][2];
#pragma unroll
            for (int m = 0; m < 4; ++m)
#pragma unroll
                for (int bj = 0; bj < 2; ++bj) { const size_t row = (size_t)u.pm * 256 + ai * 128 + wr * 64 + m * 16 + fr, col = (size_t)u.pn * 256 + bj * 128 + wc * 32 + fq * 8;
                    G0[m][bj] = *(const u32x4*)(GTp + ((size_t)sub * MH + row) * D + col);
                    G1[m][bj] = *(const u32x4*)(GTp + ((size_t)(sub < 2 ? sub + 1 : sub) * MH + row) * D + col); }
#pragma unroll
            for (int m = 0; m < 4; ++m)
#pragma unroll
                for (int bj = 0; bj < 2; ++bj) asm volatile("" : "+v"(G0[m][bj]), "+v"(G1[m][bj]));
#pragma unroll
            for (int m = 0; m < 4; ++m) { const size_t row = (size_t)u.pm * 256 + ai * 128 + wr * 64 + m * 16 + fr;
#pragma unroll
                for (int bj = 0; bj < 2; ++bj) { const size_t col = (size_t)u.pn * 256 + bj * 128 + wc * 32 + fq * 8;
                    const u32x4 g0 = G0[m][bj];
                    f32x4 s0 = {hlo(g0.x), hhi(g0.x), hlo(g0.y), hhi(g0.y)}, s1 = {hlo(g0.z), hhi(g0.z), hlo(g0.w), hhi(g0.w)};
                    if (sub < 2) { const u32x4 g1 = G1[m][bj];
                        const f32x4 t0 = {hlo(g1.x), hhi(g1.x), hlo(g1.y), hhi(g1.y)}, t1 = {hlo(g1.z), hhi(g1.z), hlo(g1.w), hhi(g1.w)};
#pragma unroll
                        for (int q = 0; q < 4; ++q) { s0[q] *= __builtin_amdgcn_rcpf(t0[q]); s1[q] *= __builtin_amdgcn_rcpf(t1[q]); } }
                    acc[ai][bj][m][0] *= s0; acc[ai][bj][m][1] *= s1;
                    if (sub == 2) *(u32x4*)(O + row * D + col) = pack8(acc[ai][bj][m][0], acc[ai][bj][m][1]); } }
        }
        return sub < 2;
    }
};

struct Ctx { LAS unsigned char* lds; int tid, lane, wave, vcu, G; };
#define FRESH_CTX(X, X_) Ctx X = X_; asm volatile("" : "+v"(X.tid), "+v"(X.lane)); asm volatile("" : "+s"(X.wave), "+s"(X.vcu))

__device__ __forceinline__ void phase_adaln(const Ctx& X_, const float* c, const float* mixw, const float* mixb, const float* ffnw, const float* ffnb, float* mod) {
    FRESH_CTX(X, X_);
    LAS float* sc = (LAS float*)X.lds; LAS float* red = sc + 8192;
    for (int i = X.tid; i < 8192; i += 512) { const float v = c[i]; sc[i] = v * sigmoidf_(v); }
    __syncthreads();
    for (int unit = X.vcu; unit < 384; unit += X.G) {
        const int l = unit / 96, w = (unit / 48) & 1, cg = unit % 48, col = cg * 64 + X.lane;
        const float* W = (w ? ffnw : mixw) + (size_t)l * 1024 * 3072; const float* bias = (w ? ffnb : mixb) + l * 3072;
        float a[8];
#pragma unroll
        for (int b = 0; b < 8; ++b) a[b] = 0.f;
        for (int k = X.wave * 128; k < X.wave * 128 + 128; ++k) { const float wv = W[(size_t)k * 3072 + col];
#pragma unroll
            for (int b = 0; b < 8; ++b) a[b] = fmaf(sc[b * 1024 + k], wv, a[b]); }
#pragma unroll
        for (int b = 0; b < 8; ++b) red[(X.wave * 8 + b) * 64 + X.lane] = a[b];
        __syncthreads();
        { const int b = X.tid >> 6; float s = bias[col];
#pragma unroll
            for (int w8 = 0; w8 < 8; ++w8) s += red[(w8 * 8 + b) * 64 + X.lane];
            mod[(((size_t)l * 2 + w) * 8 + b) * 3072 + col] = s; }
        __syncthreads();
    }
}

struct MapId { __device__ __forceinline__ int operator()(int n) const { return n; } };
struct MapWin { __device__ __forceinline__ int operator()(int n) const {
    if (n < 1792) return n;
    if (n < 2048) { const int c = n - 1792; return c < 32 ? 1792 + c : (c < 40 ? 1824 + (c - 32) : (c < 56 ? 3880 + (c - 40) : -1)); }
    if (n < 2560) return 1832 + (n - 2048);
    if (n < 2816) return 2344 + (n - 2560);
    if (n < 3072) return 2600 + (n - 2816);
    if (n < 3584) return 2856 + (n - 3072);
    if (n < 4096) return 3368 + (n - 3584);
    return 3896 + (n - 4096); } };
struct MapWinLo { __device__ __forceinline__ int operator()(int n) const { return MapWin()(1536 + n); } };
struct MapUp { __device__ __forceinline__ int operator()(int n) const { const int pn = n >> 8, r = n & 255; return r < 128 ? 128 * pn + r : DFF + 128 * pn + (r - 128); } };
struct MapGlu { __device__ __forceinline__ int operator()(int n) const { const int pn = n >> 8, r = n & 255; return r < 128 ? 128 * pn + r : 512 + 128 * pn + (r - 128); } };
template <class Map, bool LO = false>
__device__ __forceinline__ void conv_item(const float* W, int K, int Nsrc, bf16_t* WT, LAS float* scr, int item, int nblk, int lane, const Map& map) {
    const int kb = item / nblk, nb = item - kb * nblk, k0 = 64 * kb, n0 = 32 * nb;
    const int n4 = 4 * (lane & 7), kr = lane >> 3; const int sc = map(n0 + n4);
    f32x4 wv[8];
    const int scl = sc >= 0 ? sc : 0;
#pragma unroll
    for (int i = 0; i < 8; ++i) wv[i] = *(const f32x4*)(W + (size_t)(k0 + 8 * i + kr) * Nsrc + scl);
#pragma unroll
    for (int i = 0; i < 8; ++i) asm volatile("" : "+v"(wv[i]));
#pragma unroll
    for (int i = 0; i < 8; ++i) { const int kk = 8 * i + kr;
#pragma unroll
        for (int e = 0; e < 4; ++e) { float x = sc >= 0 ? wv[i][e] : 0.f; if (LO) x -= (float)(_Float16)x; scr[kk * 33 + n4 + e] = x; } }
    LDS_WAIT(); asm volatile("" ::: "memory");
    const int c = lane & 7;
#pragma unroll
    for (int j = 0; j < 4; ++j) { const int n = (lane >> 3) + 8 * j; const LAS float* s = scr + (8 * c) * 33 + n;
        u32x4 o; o.x = pk2(s[0 * 33], s[1 * 33]); o.y = pk2(s[2 * 33], s[3 * 33]); o.z = pk2(s[4 * 33], s[5 * 33]); o.w = pk2(s[6 * 33], s[7 * 33]);
        *(u32x4*)(WT + (size_t)(n0 + n) * K + k0 + 8 * c) = o; }
    LDS_WAIT(); asm volatile("" ::: "memory");
}
__device__ __forceinline__ void phase_convert(const Ctx& X_, unsigned char* ws, const float* w_in, const float* w_glu, const float* w_br, const float* w_out, const float* w_up, const float* w_dn) {
    FRESH_CTX(X, X_);
    LAS float* scr = (LAS float*)(X.lds + X.wave * 8704);
    const int gw = X.vcu * 8 + X.wave, NGW = X.G * 8;
    constexpr int I1 = 16 * 224, I2 = 8 * 32, I3 = 8 * 32, I4 = 16 * 32, I5 = 16 * 176, I6 = 44 * 32, I7 = 16 * 16, NIT = I1 + I2 + 3 * I3 + I4 + I5 + I6 + I7;
    for (int it = gw; it < NIT; it += NGW) {
        int r = it;
        if (r < I1) { conv_item(w_in, 1024, D_IN, (bf16_t*)(ws + WS_WIN), scr, r, 224, X.lane, MapWin()); continue; } r -= I1;
        if (r < I2) { conv_item(w_glu, 512, 1024, (bf16_t*)(ws + WS_WGLU), scr, r, 32, X.lane, MapGlu()); continue; } r -= I2;
        if (r < 3 * I3) { const int br = r / I3; conv_item(w_br + (size_t)br * 512 * 1024, 512, 1024, (bf16_t*)(ws + WS_WBR) + (size_t)br * 1024 * 512, scr, r - br * I3, 32, X.lane, MapId()); continue; } r -= 3 * I3;
        if (r < I4) { conv_item(w_out, 1024, 1024, (bf16_t*)(ws + WS_WOUT), scr, r, 32, X.lane, MapId()); continue; } r -= I4;
        if (r < I5) { conv_item(w_up, 1024, DUP, (bf16_t*)(ws + WS_WUP), scr, r, 176, X.lane, MapUp()); continue; } r -= I5;
        if (r < I6) { conv_item(w_dn, DFF, 1024, (bf16_t*)(ws + WS_WDN), scr, r, 32, X.lane, MapId()); continue; } r -= I6;
        if (IDX_SPLIT) conv_item<MapWinLo, true>(w_in, 1024, D_IN, (bf16_t*)(ws + WS_WINLO), scr, r, 16, X.lane, MapWinLo());
    }
}

__device__ __forceinline__ void phase_s5pre(const Ctx& X_, unsigned char* ws, const float* lam_re, const float* lam_im, const float* log_dt, const float* b_re, const float* b_im, const float* c_re, const float* c_im) {
    FRESH_CTX(X, X_);
    LAS float* pw = (LAS float*)X.lds;
    LAS float* bbr = pw + 384; LAS float* bbi = bbr + 1024; LAS float* cr = bbi + 1024; LAS float* ci = cr + 1024;
    bf16_t* BO = (bf16_t*)(ws + WS_S5BO); bf16_t* BS = (bf16_t*)(ws + WS_S5BS);
    for (int item = X.vcu; item < 256; item += X.G) {
        const int g = item >> 3, tq = item & 7;
        __syncthreads();
        const float dt = expf(log_dt[g]);
        for (int e = X.tid; e < 1024; e += 512) { const int n = e >> 4; const float lr = lam_re[g * 64 + n], li = lam_im[g * 64 + n];
            const float mag = expf(lr * dt), ar = mag * cosf(li * dt), ai = mag * sinf(li * dt), den = lr * lr + li * li, nr = ar - 1.0f, ni = ai;
            const float fr_ = (nr * lr + ni * li) / den, fi_ = (ni * lr - nr * li) / den; const float br = b_re[(size_t)g * 1024 + e], bi = b_im[(size_t)g * 1024 + e];
            bbr[e] = fr_ * br - fi_ * bi; bbi[e] = fr_ * bi + fi_ * br; }
        for (int e = X.tid; e < 1024; e += 512) { cr[e] = c_re[(size_t)g * 1024 + e]; ci[e] = c_im[(size_t)g * 1024 + e]; }
        for (int ti = 0; ti < 4; ++ti) { const int tau = tq + 8 * ti;
            if (ti) __syncthreads();
            if (X.tid < 192) { const int which = X.tid >> 6, n = X.tid & 63; const float e = which == 0 ? (float)tau : (which == 1 ? (float)(tau + 1) : (float)(31 - tau));
                const float lr = lam_re[g * 64 + n], li = lam_im[g * 64 + n], mag = expf(lr * dt * e), ang = li * dt * e; pw[which * 128 + n] = mag * cosf(ang); pw[which * 128 + 64 + n] = mag * sinf(ang); }
            __syncthreads();
            if (X.tid < 256) {
                const int po = X.tid >> 4, pi = X.tid & 15; float k = 0.f;
                for (int n = 0; n < 64; ++n) { const float c_r = cr[po * 64 + n], c_i = ci[po * 64 + n], p_r = pw[n], p_i = pw[64 + n]; k += (c_r * p_r - c_i * p_i) * bbr[n * 16 + pi] - (c_r * p_i + c_i * p_r) * bbi[n * 16 + pi]; }
                const bf16_t kh = f2h(k);
                for (int j = tau; j < 32; ++j) BO[((size_t)g * 512 + j * 16 + po) * S5K + (j - tau) * 16 + pi] = kh;
                for (int j = 0; j + tau + 1 < 32; ++j) BO[((size_t)g * 512 + j * 16 + po) * S5K + (j + tau + 1) * 16 + pi] = 0;
            } else {
                const int t2 = X.tid - 256;
                { const int po = t2 >> 4, x = t2 & 15; bf16_t* orow = BO + ((size_t)g * 512 + tau * 16 + po) * S5K;
#pragma unroll
                    for (int q = 0; q < 4; ++q) { const int n = x + 16 * q; const float c_r = cr[po * 64 + n], c_i = ci[po * 64 + n], p_r = pw[128 + n], p_i = pw[192 + n];
                        orow[512 + n] = f2h(c_r * p_r - c_i * p_i); orow[576 + n] = f2h(-(c_r * p_i + c_i * p_r)); } }
                { const int row = t2; float v[16];
#pragma unroll
                    for (int q = 0; q < 16; ++q) { v[q] = 0.f; if (row < 128) { const int n = row & 63; const float p_r = pw[256 + n], p_i = pw[320 + n], b_r = bbr[n * 16 + q], b_i = bbi[n * 16 + q];
                            v[q] = row < 64 ? p_r * b_r - p_i * b_i : p_r * b_i + p_i * b_r; } }
                    u32x4 o0, o1; o0.x = pk2(v[0], v[1]); o0.y = pk2(v[2], v[3]); o0.z = pk2(v[4], v[5]); o0.w = pk2(v[6], v[7]); o1.x = pk2(v[8], v[9]); o1.y = pk2(v[10], v[11]); o1.z = pk2(v[12], v[13]); o1.w = pk2(v[14], v[15]);
                    bf16_t* dst = BS + ((size_t)g * 256 + row) * 512 + tau * 16; *(u32x4*)dst = o0; *(u32x4*)(dst + 8) = o1; }
            }
        }
    }
}

#define ROWCOL(lane, j) (8 * (lane) + 4 * ((j) & 1) + 512 * ((j) >> 1))
__device__ __forceinline__ void row_load_f32(const float* p, int lane, f32x4 (&v)[4]) {
#pragma unroll
    for (int j = 0; j < 4; ++j) v[j] = *(const f32x4*)(p + ROWCOL(lane, j));
}
__device__ __forceinline__ void row_load_bf16(const bf16_t* p, int lane, f32x4 (&v)[4]) {
#pragma unroll
    for (int jj = 0; jj < 2; ++jj) { const u32x4 w = *(const u32x4*)(p + 8 * lane + 512 * jj); v[2 * jj] = (f32x4){hlo(w.x), hhi(w.x), hlo(w.y), hhi(w.y)}; v[2 * jj + 1] = (f32x4){hlo(w.z), hhi(w.z), hlo(w.w), hhi(w.w)}; }
}
__device__ __forceinline__ float row_rstd(const f32x4 (&v)[4]) {
    float s = 0.f;
#pragma unroll
    for (int j = 0; j < 4; ++j) s += (v[j][0] * v[j][0] + v[j][1] * v[j][1]) + (v[j][2] * v[j][2] + v[j][3] * v[j][3]);
    return rsqrtf(wave_sum(s) * (1.0f / 1024.0f) + EPS);
}
__device__ __forceinline__ void row_modulate_store(const f32x4 (&v)[4], float rstd, const float* g, const float* modv  , bf16_t* o, bf16_t* olo, int lane) {
    (void)olo;
#pragma unroll
    for (int jj = 0; jj < 2; ++jj) { u32x4 w;
#pragma unroll
        for (int q = 0; q < 2; ++q) { const int j = 2 * jj + q, c = ROWCOL(lane, j); const f32x4 gg = *(const f32x4*)(g + c), sh = *(const f32x4*)(modv + c), scl = *(const f32x4*)(modv + 1024 + c);
            const f32x4 h = v[j] * rstd * gg * (scl + 1.0f) + sh; if (q == 0) { w.x = pk2(h[0], h[1]); w.y = pk2(h[2], h[3]); } else { w.z = pk2(h[0], h[1]); w.w = pk2(h[2], h[3]); } }
        *(u32x4*)(o + 8 * lane + 512 * jj) = w; }
}
__device__ __forceinline__ void row_rstd2(const f32x4 (&a)[4], const f32x4 (&b)[4], float& ra, float& rb) {
    float sa = 0.f, sb = 0.f;
#pragma unroll
    for (int j = 0; j < 4; ++j) { sa += (a[j][0] * a[j][0] + a[j][1] * a[j][1]) + (a[j][2] * a[j][2] + a[j][3] * a[j][3]); sb += (b[j][0] * b[j][0] + b[j][1] * b[j][1]) + (b[j][2] * b[j][2] + b[j][3] * b[j][3]); }
#pragma unroll
    for (int o = 1; o < 64; o <<= 1) { sa += __shfl_xor(sa, o); sb += __shfl_xor(sb, o); }
    ra = rsqrtf(sa * (1.0f / 1024.0f) + EPS); rb = rsqrtf(sb * (1.0f / 1024.0f) + EPS);
}
__device__ __forceinline__ void phase_t1(const Ctx& X_, const float* xsrc, int hb, int l, const float* pre_g, const float* mod, bf16_t* H, bf16_t* HLO) {
    FRESH_CTX(X, X_);
    const int gw = X.vcu * 8 + X.wave, NGW = X.G * 8;
    for (int r = gw; r < MH; r += 2 * NGW) { const int r2 = r + NGW < MH ? r + NGW : r; const size_t Ra = (size_t)hb * MH + r, Rb = (size_t)hb * MH + r2;
        f32x4 va[4], vb[4]; row_load_f32(xsrc + Ra * D, X.lane, va); row_load_f32(xsrc + Rb * D, X.lane, vb); float ra, rb; row_rstd2(va, vb, ra, rb);
        row_modulate_store(va, ra, pre_g + l * D, mod + (((size_t)l * 2 + 0) * 8 + (int)(Ra >> 12)) * 3072, H + (size_t)r * D, HLO ? HLO + (size_t)r * D : nullptr, X.lane);
        row_modulate_store(vb, rb, pre_g + l * D, mod + (((size_t)l * 2 + 0) * 8 + (int)(Rb >> 12)) * 3072, H + (size_t)r2 * D, HLO ? HLO + (size_t)r2 * D : nullptr, X.lane); }
}
__device__ __forceinline__ void row_store_x16(bf16_t* p, int lane, const f32x4 (&v)[4]) {
#pragma unroll
    for (int jj = 0; jj < 2; ++jj) { u32x4 w; w.x = pk2(v[2 * jj][0], v[2 * jj][1]); w.y = pk2(v[2 * jj][2], v[2 * jj][3]); w.z = pk2(v[2 * jj + 1][0], v[2 * jj + 1][1]); w.w = pk2(v[2 * jj + 1][2], v[2 * jj + 1][3]);
        *(u32x4*)(p + 8 * lane + 512 * jj) = w; }
}
__device__ __forceinline__ void phase_t2(const Ctx& X_, const float* xin, const bf16_t* xs, bf16_t* xd, int hb, int l, const bf16_t* Y, const float* post_g, const float* fpre_g, const float* mod, bf16_t* HF) {
    FRESH_CTX(X, X_);
    const int gw = X.vcu * 8 + X.wave, NGW = X.G * 8;
    for (int r = gw; r < MH; r += 2 * NGW) { const int r2 = r + NGW < MH ? r + NGW : r; const size_t Ra = (size_t)hb * MH + r, Rb = (size_t)hb * MH + r2; const int ba = (int)(Ra >> 12), bb = (int)(Rb >> 12);
        f32x4 ya[4], yb[4], va[4], vb[4]; row_load_bf16(Y + (size_t)r * D, X.lane, ya); row_load_bf16(Y + (size_t)r2 * D, X.lane, yb);
        if (xin) { row_load_f32(xin + Ra * D, X.lane, va); row_load_f32(xin + Rb * D, X.lane, vb); } else { row_load_bf16(xs + (size_t)r * D, X.lane, va); row_load_bf16(xs + (size_t)r2 * D, X.lane, vb); }
        float rya, ryb; row_rstd2(ya, yb, rya, ryb);
        const float* mva = mod + (((size_t)l * 2 + 0) * 8 + ba) * 3072; const float* mvb = mod + (((size_t)l * 2 + 0) * 8 + bb) * 3072;
#pragma unroll
        for (int j = 0; j < 4; ++j) { const int c = ROWCOL(X.lane, j); const f32x4 gg = *(const f32x4*)(post_g + l * D + c), gta = *(const f32x4*)(mva + 2048 + c), gtb = *(const f32x4*)(mvb + 2048 + c);
            va[j] = va[j] + gta * (ya[j] * rya * gg); vb[j] = vb[j] + gtb * (yb[j] * ryb * gg); }
        row_store_x16(xd + (size_t)r * D, X.lane, va); if (r2 != r) row_store_x16(xd + (size_t)r2 * D, X.lane, vb);
        float ra, rb; row_rstd2(va, vb, ra, rb);
        row_modulate_store(va, ra, fpre_g + l * D, mod + (((size_t)l * 2 + 1) * 8 + ba) * 3072, HF + (size_t)r * D, nullptr, X.lane);
        if (r2 != r) row_modulate_store(vb, rb, fpre_g + l * D, mod + (((size_t)l * 2 + 1) * 8 + bb) * 3072, HF + (size_t)r2 * D, nullptr, X.lane); }
}
__device__ __forceinline__ void phase_t4(const Ctx& X_, const bf16_t* xs, bf16_t* xd, float* outf, bf16_t* Hn, int hb, int l, const bf16_t* Y2, const float* fpost_g, const float* pre_g, const float* mod) {
    FRESH_CTX(X, X_);
    const int gw = X.vcu * 8 + X.wave, NGW = X.G * 8;
    for (int r = gw; r < MH; r += 2 * NGW) { const int r2 = r + NGW < MH ? r + NGW : r; const size_t Ra = (size_t)hb * MH + r, Rb = (size_t)hb * MH + r2; const int ba = (int)(Ra >> 12), bb = (int)(Rb >> 12);
        f32x4 ya[4], yb[4], va[4], vb[4]; row_load_bf16(Y2 + (size_t)r * D, X.lane, ya); row_load_bf16(Y2 + (size_t)r2 * D, X.lane, yb); row_load_bf16(xs + (size_t)r * D, X.lane, va); row_load_bf16(xs + (size_t)r2 * D, X.lane, vb);
        float rya, ryb; row_rstd2(ya, yb, rya, ryb);
        const float* mva = mod + (((size_t)l * 2 + 1) * 8 + ba) * 3072; const float* mvb = mod + (((size_t)l * 2 + 1) * 8 + bb) * 3072;
#pragma unroll
        for (int j = 0; j < 4; ++j) { const int c = ROWCOL(X.lane, j); const f32x4 gg = *(const f32x4*)(fpost_g + l * D + c), gta = *(const f32x4*)(mva + 2048 + c), gtb = *(const f32x4*)(mvb + 2048 + c);
            va[j] = va[j] + gta * (ya[j] * rya * gg); vb[j] = vb[j] + gtb * (yb[j] * ryb * gg); }
        if (outf) {
#pragma unroll
            for (int j = 0; j < 4; ++j) { const int c = ROWCOL(X.lane, j); *(f32x4*)(outf + Ra * D + c) = va[j]; if (r2 != r) *(f32x4*)(outf + Rb * D + c) = vb[j]; }
        } else {
            row_store_x16(xd + (size_t)r * D, X.lane, va); if (r2 != r) row_store_x16(xd + (size_t)r2 * D, X.lane, vb);
            float ra, rb; row_rstd2(va, vb, ra, rb);
            row_modulate_store(va, ra, pre_g + (l + 1) * D, mod + (((size_t)(l + 1) * 2 + 0) * 8 + ba) * 3072, Hn + (size_t)r * D, nullptr, X.lane);
            if (r2 != r) row_modulate_store(vb, rb, pre_g + (l + 1) * D, mod + (((size_t)(l + 1) * 2 + 0) * 8 + bb) * 3072, Hn + (size_t)r2 * D, nullptr, X.lane); }
    }
}
__device__ __forceinline__ void upfix_panel(const Ctx& X_, const bf16_t* EDGE, const float* cw  , const float* cb  , bf16_t* ACT, int pm) {
    FRESH_CTX(X, X_);
    if ((pm & 15) == 0) return;
    for (int c = X.tid; c < DFF; c += 512) {
        const int pn = c >> 7, lc = c & 127;
        const bf16_t* e = EDGE + ((size_t)pm * 22 + pn) * 1024; const bf16_t* ep = EDGE + ((size_t)(pm - 1) * 22 + pn) * 1024 + 512;
        const float ga = h2f(e[lc]), gb_ = h2f(e[256 + lc]), va = h2f(e[128 + lc]), vb_ = h2f(e[256 + 128 + lc]);
        const float g2p = h2f(ep[lc]), g1p = h2f(ep[256 + lc]), v2p = h2f(ep[128 + lc]), v1p = h2f(ep[256 + 128 + lc]);
        const float wg0 = cw[c], wg1 = cw[DUP + c], wg2 = cw[2 * DUP + c], bg = cb[c], wv0 = cw[DFF + c], wv1 = cw[DUP + DFF + c], wv2 = cw[2 * DUP + DFF + c], bv = cb[DFF + c];
        const float gA = wg2 * ga + wg1 * g1p + wg0 * g2p + bg, vA = wv2 * va + wv1 * v1p + wv0 * v2p + bv;
        const float gB = wg2 * gb_ + wg1 * ga + wg0 * g1p + bg, vB = wv2 * vb_ + wv1 * va + wv0 * v1p + bv;
        ACT[((size_t)pm * 256) * DFF + c] = f2h(gelu_tanh(gA) * vA); ACT[((size_t)pm * 256 + 1) * DFF + c] = f2h(gelu_tanh(gB) * vB);
    }
}
__device__ __forceinline__ void phase_scans(const Ctx& X_, unsigned char* reg, const float* lam_re, const float* lam_im, const float* log_dt) {
    FRESH_CTX(X, X_);
    const bool s5w = X.wave == 7 && X.lane < 32;
    for (int wg = X.vcu; wg < 256; wg += X.G) {
        const int e = wg * 512 + X.tid;
        const int d = e & 63, ee = (e >> 6) & 127, bh = e >> 13, h = bh & 3, b = bh >> 2;
        const float* kv = (const float*)(reg + R_KVT) + (size_t)bh * 64 * 8192 + ee * 64 + d; const float* dc = (const float*)(reg + R_DEC) + (size_t)b * 64 * 256 + h * 64 + d;
        bf16_t* st = (bf16_t*)(reg + R_ST) + (size_t)bh * 64 * 8192 + ee * 64 + d;
        const int e5 = wg * 32 + (X.lane & 31); const int n5 = e5 & 63, g5 = (e5 >> 6) & 31, b5 = e5 >> 11;
        const float* sc5 = (const float*)(reg + R_S5SC) + ((size_t)g5 * 512 + b5 * 128) * 128 + n5; bf16_t* A5 = (bf16_t*)(reg + R_S5A) + ((size_t)g5 * 512 + b5 * 128) * S5K + 512 + n5;
        float ar = 0.f, ai = 0.f;
        if (s5w) { const float dt = expf(log_dt[g5]), lr = lam_re[g5 * 64 + n5], li = lam_im[g5 * 64 + n5]; const float mag = expf(lr * dt * 32.0f), ang = li * dt * 32.0f; ar = mag * cosf(ang); ai = mag * sinf(ang); }
        float S = 0.f, Sr = 0.f, Si = 0.f;
        for (int bt = 0; bt < 4; ++bt) { float kvv[16], dd[16];
#pragma unroll
            for (int q = 0; q < 16; ++q) { kvv[q] = kv[(size_t)(bt * 16 + q) * 8192]; dd[q] = dc[(size_t)(bt * 16 + q) * 256]; }
            if (s5w) { float xr[32], xi[32];
#pragma unroll
                for (int q = 0; q < 32; ++q) { xr[q] = sc5[(size_t)(bt * 32 + q) * 128]; xi[q] = sc5[(size_t)(bt * 32 + q) * 128 + 64]; }
#pragma unroll
                for (int q = 0; q < 32; ++q) { A5[(size_t)(bt * 32 + q) * S5K] = f2h(Sr); A5[(size_t)(bt * 32 + q) * S5K + 64] = f2h(Si);
                    const float nr = ar * Sr - ai * Si + xr[q], ni = ar * Si + ai * Sr + xi[q]; Sr = nr; Si = ni; } }
#pragma unroll
            for (int q = 0; q < 16; ++q) { st[(size_t)(bt * 16 + q) * 8192] = f2b(S); S = dd[q] * S + kvv[q]; } }
    }
}

__device__ __forceinline__ f32x16 mfma32(const bf16x8 a, const bf16x8 b, const f32x16 c) { return __builtin_amdgcn_mfma_f32_32x32x16_bf16(a, b, c, 0, 0, 0); }
__device__ __forceinline__ f32x16 zero16() { f32x16 z; for (int i = 0; i < 16; ++i) z[i] = 0.f; return z; }
__device__ __forceinline__ int crow(int r, int half) { return (r & 3) + 8 * (r >> 2) + 4 * half; }

__device__ __forceinline__ void gla_c1(const Ctx& X_, unsigned char* reg, const float* wgate, const float* bgate, int b, int ch) {
    FRESH_CTX(X, X_);
    LAS float* glrs = (LAS float*)X.lds; LAS float* tot = glrs + 1024;
    LAS bf16_t* ktT = (LAS bf16_t*)(X.lds + 8192); LAS bf16_t* vT = ktT + 4 * 64 * 72;
    const size_t row0 = (size_t)b * 4096 + (size_t)ch * 64; const size_t bc = (size_t)b * 64 + ch;
    const bf16_t* GQ = (const bf16_t*)(reg + R_GQ); const bf16_t* GK = (const bf16_t*)(reg + R_GK); const bf16_t* GV = (const bf16_t*)(reg + R_GV);
    __syncthreads();
    for (int i = X.tid; i < 1024; i += 512) glrs[i] = ((const float*)(reg + R_GLR))[row0 * 16 + i];
#pragma unroll
    for (int it = 0; it < 8; ++it) { const int tok = X.tid & 63, c8 = (it * 8 + (X.tid >> 6)) * 8; const u32x4 v = *(const u32x4*)(GV + (row0 + tok) * 512 + c8);
        LAS bf16_t* dst = vT + (size_t)c8 * 72 + tok;
#pragma unroll
        for (int q = 0; q < 4; ++q) { dst[(2 * q) * 72] = f2b(hlo(v[q])); dst[(2 * q + 1) * 72] = f2b(hhi(v[q])); } }
    __syncthreads();
    const int c = X.tid & 255, jh = X.tid >> 8, h = c >> 6, d = c & 63;
    float wg[16];
#pragma unroll
    for (int r = 0; r < 16; ++r) wg[r] = wgate[r * 256 + c];
    const float bg = bgate[c];
    unsigned short qraw[32], kraw[32];
#pragma unroll
    for (int jj = 0; jj < 32; ++jj) { qraw[jj] = GQ[(row0 + jh * 32 + jj) * 256 + c]; kraw[jj] = GK[(row0 + jh * 32 + jj) * 256 + c]; }
    float run = 0.f;
#pragma unroll 2
    for (int jj = 0; jj < 32; ++jj) { const int j = jh * 32 + jj; float x = bg;
#pragma unroll
        for (int r = 0; r < 16; ++r) x = fmaf(glrs[j * 16 + r], wg[r], x);
        run += (fminf(x, 0.f) - __logf(1.0f + __expf(-fabsf(x)))) * 0.0625f; }
    tot[jh * 256 + c] = run;
    __syncthreads();
    const float last = tot[c] + tot[256 + c];
    float cumv = jh ? tot[c] : 0.f;
    bf16_t* QD = (bf16_t*)(reg + R_QD) + ((bc * 4 + h) * 64) * 64 + d; bf16_t* KI = (bf16_t*)(reg + R_KI) + ((bc * 4 + h) * 64) * 64 + d;
#pragma unroll
    for (int jj = 0; jj < 32; ++jj) { const int j = jh * 32 + jj; float x = bg;
#pragma unroll
        for (int r = 0; r < 16; ++r) x = fmaf(glrs[j * 16 + r], wg[r], x);
        cumv += (fminf(x, 0.f) - __logf(1.0f + __expf(-fabsf(x)))) * 0.0625f;
        const float q = h2f(qraw[jj]), k = h2f(kraw[jj]);
        QD[(size_t)j * 64] = f2b(q * 0.125f * __expf(cumv)); KI[(size_t)j * 64] = f2b(k * __expf(-cumv));
        ktT[(h * 64 + d) * 72 + j] = f2b(k * __expf(last - cumv)); }
    if (jh == 1) ((float*)(reg + R_DEC))[bc * 256 + c] = expf(last);
    __syncthreads();
    bf16_t* VTg = (bf16_t*)(reg + R_VT) + bc * 512 * 64;
#pragma unroll
    for (int it = 0; it < 8; ++it) { const int idx = it * 512 + X.tid, row = idx >> 3, c16 = idx & 7; *(u32x4*)(VTg + (size_t)row * 64 + c16 * 8) = *(const LAS u32x4*)(vT + row * 72 + c16 * 8); }
    {
        const int hh = X.wave >> 1, half = X.lane >> 5, l31 = X.lane & 31;
        float* KVT = (float*)(reg + R_KVT) + (((size_t)b * 4 + hh) * 64 + ch) * 8192;
#pragma unroll
        for (int et = 0; et < 2; ++et)
#pragma unroll
            for (int dt2 = 0; dt2 < 2; ++dt2) { const int etile = 2 * (X.wave & 1) + et; f32x16 acc = zero16();
#pragma unroll
                for (int ks = 0; ks < 4; ++ks) { const bf16x8 a = *(const LAS bf16x8*)(vT + (hh * 128 + etile * 32 + l31) * 72 + ks * 16 + half * 8);
                    const bf16x8 bb = *(const LAS bf16x8*)(ktT + (hh * 64 + dt2 * 32 + l31) * 72 + ks * 16 + half * 8); acc = mfma32(a, bb, acc); }
#pragma unroll
                for (int r = 0; r < 16; ++r) KVT[(size_t)(etile * 32 + crow(r, half)) * 64 + dt2 * 32 + l31] = acc[r]; }
    }
}
__device__ __forceinline__ void gla_c3(const Ctx& X_, unsigned char* reg, const float* normg  , int b, int ch) {
    FRESH_CTX(X, X_);
    const int hh = X.wave >> 1, ih = X.wave & 1, half = X.lane >> 5, l31 = X.lane & 31; const size_t bc = (size_t)b * 64 + ch;
    const bf16_t* qd = (const bf16_t*)(reg + R_QD) + ((bc * 4 + hh) * 64) * 64; const bf16_t* ki = (const bf16_t*)(reg + R_KI) + ((bc * 4 + hh) * 64) * 64;
    const bf16_t* vt = (const bf16_t*)(reg + R_VT) + ((bc * 4 + hh) * 128) * 64; const bf16_t* st = (const bf16_t*)(reg + R_ST) + ((((size_t)b * 4 + hh) * 64 + ch) * 128) * 64;
    const size_t R = (size_t)b * 4096 + (size_t)ch * 64 + 32 * ih + l31;
    const bf16_t* GR = (const bf16_t*)(reg + R_GR) + R * 512 + hh * 128; bf16_t* YC = (bf16_t*)(reg + R_YS) + ((size_t)2 * MH + R) * 512 + hh * 128;
    bf16x8 qf[4], kf[2][4], sf[4][4];
#pragma unroll
    for (int ks = 0; ks < 4; ++ks) qf[ks] = *(const bf16x8*)(qd + (size_t)(32 * ih + l31) * 64 + ks * 16 + half * 8);
#pragma unroll
    for (int ks = 0; ks < 4; ++ks) kf[0][ks] = *(const bf16x8*)(ki + (size_t)l31 * 64 + ks * 16 + half * 8);
#pragma unroll
    for (int et = 0; et < 4; ++et)
#pragma unroll
        for (int ks = 0; ks < 4; ++ks) sf[et][ks] = *(const bf16x8*)(st + (size_t)(et * 32 + l31) * 64 + ks * 16 + half * 8);
    f32x16 o[4];
#pragma unroll
    for (int et = 0; et < 4; ++et) { o[et] = zero16();
#pragma unroll
        for (int ks = 0; ks < 4; ++ks) o[et] = mfma32(sf[et][ks], qf[ks], o[et]); }
#pragma unroll
    for (int et = 0; et < 4; ++et) asm volatile("" : "+v"(o[et]) :: "memory");
    u32x2 vlo[2][4][2], vhi[2][4][2], grr[4][4];
#pragma unroll
    for (int et = 0; et < 4; ++et)
#pragma unroll
        for (int sp = 0; sp < 2; ++sp) { const bf16_t* vp = vt + (size_t)(et * 32 + l31) * 64 + sp * 16 + half * 4; vlo[0][et][sp] = *(const u32x2*)vp; vhi[0][et][sp] = *(const u32x2*)(vp + 8); }
#pragma unroll
    for (int ks = 0; ks < 4; ++ks) kf[1][ks] = *(const bf16x8*)(ki + (size_t)(ih * 32 + l31) * 64 + ks * 16 + half * 8);
#pragma unroll
    for (int stl = 0; stl < 2; ++stl) if (stl <= ih) {
        f32x16 at = zero16();
#pragma unroll
        for (int ks = 0; ks < 4; ++ks) at = mfma32(kf[stl][ks], qf[ks], at);
        if (stl == ih) {
#pragma unroll
            for (int r = 0; r < 16; ++r) if (crow(r, half) > l31) at[r] = 0.f; }
        bf16x8 pf[2];
#pragma unroll
        for (int sp = 0; sp < 2; ++sp) { u32x4 w; w.x = pk2b(at[8 * sp + 0], at[8 * sp + 1]); w.y = pk2b(at[8 * sp + 2], at[8 * sp + 3]); w.z = pk2b(at[8 * sp + 4], at[8 * sp + 5]); w.w = pk2b(at[8 * sp + 6], at[8 * sp + 7]); pf[sp] = __builtin_bit_cast(bf16x8, w); }
#pragma unroll
        for (int et = 0; et < 4; ++et)
#pragma unroll
            for (int sp = 0; sp < 2; ++sp) { u32x4 w; w.x = vlo[stl][et][sp].x; w.y = vlo[stl][et][sp].y; w.z = vhi[stl][et][sp].x; w.w = vhi[stl][et][sp].y;
                o[et] = mfma32(__builtin_bit_cast(bf16x8, w), pf[sp], o[et]); }
        if (stl == 0) {
#pragma unroll
            for (int et = 0; et < 4; ++et) asm volatile("" : "+v"(o[et]) :: "memory");
#pragma unroll
            for (int et = 0; et < 4; ++et)
#pragma unroll
                for (int sp = 0; sp < 2; ++sp) { const bf16_t* vp = vt + (size_t)(et * 32 + l31) * 64 + ih * 32 + sp * 16 + half * 4; vlo[1][et][sp] = *(const u32x2*)vp; vhi[1][et][sp] = *(const u32x2*)(vp + 8); }
#pragma unroll
            for (int et = 0; et < 4; ++et)
#pragma unroll
                for (int g4 = 0; g4 < 4; ++g4) grr[et][g4] = *(const u32x2*)(GR + et * 32 + 8 * g4 + 4 * half); }
    }
    float ss = 0.f;
#pragma unroll
    for (int et = 0; et < 4; ++et)
#pragma unroll
        for (int r = 0; r < 16; ++r) ss += o[et][r] * o[et][r];
    ss += __shfl_xor(ss, 32);
    const float rstd = rsqrtf(ss * (1.0f / 128.0f) + EPS);
#pragma unroll
    for (int et = 0; et < 4; ++et) { f32x4 ngv[4];
#pragma unroll
        for (int g4 = 0; g4 < 4; ++g4) ngv[g4] = *(const f32x4*)(normg + hh * 128 + et * 32 + 8 * g4 + 4 * half);
#pragma unroll
        for (int g4 = 0; g4 < 4; ++g4) asm volatile("" : "+v"(ngv[g4]));
#pragma unroll
        for (int g4 = 0; g4 < 4; ++g4) { const int e0 = et * 32 + 8 * g4 + 4 * half; const f32x4 ng = ngv[g4]; const u32x2 rr = grr[et][g4];
            const float r0 = hlo(rr.x), r1 = hhi(rr.x), r2 = hlo(rr.y), r3 = hhi(rr.y);
            const float v0 = o[et][4 * g4 + 0] * rstd * ng[0] * (r0 * sigmoidf_(r0)), v1 = o[et][4 * g4 + 1] * rstd * ng[1] * (r1 * sigmoidf_(r1));
            const float v2 = o[et][4 * g4 + 2] * rstd * ng[2] * (r2 * sigmoidf_(r2)), v3 = o[et][4 * g4 + 3] * rstd * ng[3] * (r3 * sigmoidf_(r3));
            u32x2 w; w.x = pk2(v0, v1); w.y = pk2(v2, v3); *(u32x2*)(YC + e0) = w; } }
}

__device__ __forceinline__ unsigned f2key(float f) { const int u = __float_as_int(f); return (unsigned)(u ^ ((u >> 31) | (int)0x80000000)); }
__device__ __forceinline__ float key2f(unsigned k) { return __uint_as_float((k & 0x80000000u) ? (k & 0x7FFFFFFFu) : ~k); }
__device__ __forceinline__ f32x16 mfma32h(const bf16x8 a, const bf16x8 b, const f32x16 c) { return __builtin_amdgcn_mfma_f32_32x32x16_f16(__builtin_bit_cast(f16x8, a), __builtin_bit_cast(f16x8, b), c, 0, 0, 0); }
struct IkFrag { bf16x8 h0, h1, l0, l1; };
__device__ __forceinline__ IkFrag ik_load(const bf16_t* ikh_seq, const bf16_t* ikl_seq, int kt, int lane) {
    const size_t ko = (size_t)(kt * 32 + (lane & 31)) * 32 + (lane >> 5) * 8; IkFrag f;
    f.h0 = *(const bf16x8*)(ikh_seq + ko); f.h1 = *(const bf16x8*)(ikh_seq + ko + 16); if (DSA_TERMS >= 3) { f.l0 = *(const bf16x8*)(ikl_seq + ko); f.l1 = *(const bf16x8*)(ikl_seq + ko + 16); } else { f.l0 = f.h0; f.l1 = f.h1; } return f;
}
__device__ __forceinline__ f32x16 dsa_chain(const IkFrag& k, const bf16x8 qh0, const bf16x8 qh1, const bf16x8 ql0, const bf16x8 ql1) {
    f32x16 dd = zero16(); dd = mfma32h(k.h0, qh0, dd); dd = mfma32h(k.h1, qh1, dd); if (DSA_TERMS >= 2) { dd = mfma32h(k.h0, ql0, dd); dd = mfma32h(k.h1, ql1, dd); }
    if (DSA_TERMS >= 3) { dd = mfma32h(k.l0, qh0, dd); dd = mfma32h(k.l1, qh1, dd); }
    return dd;
}
__device__ __forceinline__ void dsa_accum(const f32x16& dd, float wh, float (&sc)[16]) {
#pragma unroll
    for (int r = 0; r < 16; ++r) { const float dv = dd[r]; sc[r] = fmaf(__builtin_fabsf(dv), wh, sc[r]); }
#pragma unroll
    for (int r = 0; r < 16; ++r) asm volatile("" : "+v"(sc[r]));
}
__device__ __forceinline__ void dsa_scores(const IkFrag& k, const bf16x8 (&qh)[8][2], const bf16x8 (&qt)[2]  , const LAS bf16x8* qlo, const float (&w)[8]  , float (&sc)[16]) {
    { f32x16 lin = zero16(); lin = mfma32h(k.h0, qt[0], lin); lin = mfma32h(k.h1, qt[1], lin);
#pragma unroll
      for (int r = 0; r < 16; ++r) sc[r] = lin[r]; }
    f32x16 da = dsa_chain(k, qh[0][0], qh[0][1], DSA_TERMS >= 2 ? qlo[0] : qh[0][0], DSA_TERMS >= 2 ? qlo[64] : qh[0][1]);
#pragma unroll
    for (int h = 0; h < 8; h += 2) {
        const f32x16 db = dsa_chain(k, qh[h + 1][0], qh[h + 1][1], DSA_TERMS >= 2 ? qlo[((h + 1) * 2 + 0) * 64] : qh[h + 1][0], DSA_TERMS >= 2 ? qlo[((h + 1) * 2 + 1) * 64] : qh[h + 1][1]);
        dsa_accum(da, w[h], sc);
        if (h + 2 < 8) da = dsa_chain(k, qh[h + 2][0], qh[h + 2][1], DSA_TERMS >= 2 ? qlo[((h + 2) * 2 + 0) * 64] : qh[h + 2][0], DSA_TERMS >= 2 ? qlo[((h + 2) * 2 + 1) * 64] : qh[h + 2][1]);
        dsa_accum(db, w[h + 1], sc);
    }
}
constexpr int DSA_SEL_OFF = 32 * 1025 * 4;
__device__ __forceinline__ void dsa_pick_bin(const LAS unsigned* hist, LAS unsigned* seg, LAS unsigned* sel_b1, LAS unsigned* sel_rem, LAS unsigned* sel_cnt, int tid, int level, LAS unsigned* big) {
    const int q = tid & 31, j = tid >> 5; const unsigned need = level ? sel_rem[q] : 256u;
    const LAS unsigned* hq = hist + (64 * j) * 32 + q; unsigned s = 0;
#pragma unroll 8
    for (int i = 0; i < 64; ++i) s += hq[i * 32];
    seg[j * 32 + q] = s;
    __syncthreads();
    unsigned above = 0;
    for (int k = j + 1; k < 16; ++k) above += seg[k * 32 + q];
    if (above < need && above + s >= need) { seg[512 + q] = (unsigned)j; seg[544 + q] = above; }
    __syncthreads();
    const unsigned jj = seg[512 + q], abv = seg[544 + q];
    const LAS unsigned* hs = hist + (64 * jj + 4 * j) * 32 + q; unsigned c4[4]; unsigned s4 = 0;
#pragma unroll
    for (int i = 0; i < 4; ++i) { c4[i] = hs[i * 32]; s4 += c4[i]; }
    seg[576 + j * 32 + q] = s4;
    __syncthreads();
    unsigned ab4 = abv;
    for (int k = j + 1; k < 16; ++k) ab4 += seg[576 + k * 32 + q];
    if (ab4 < need && ab4 + s4 >= need) {
        unsigned run = ab4; unsigned b1 = 0, rem = 1, cb = 0; bool found = false;
#pragma unroll
        for (int i = 3; i >= 0; --i) if (!found) { if (run + c4[i] >= need) { b1 = (unsigned)(64 * jj + 4 * j + i); rem = need - run; cb = c4[i]; found = true; } else run += c4[i]; }
        sel_b1[q] = level ? ((sel_b1[q] << 10) | b1) : b1; sel_rem[q] = rem; sel_cnt[q] = 0u;
        if (big != nullptr && cb > 256u) *big = 1u;
    }
}
__device__ __forceinline__ void dsa_bit_ge(unsigned& bits, float t, float thr) { asm("v_cmp_ge_f32 vcc, %1, %2\n\tv_addc_co_u32 %0, vcc, %0, %0, vcc" : "+v"(bits) : "v"(t), "v"(thr) : "vcc"); }
#define DSA_BITS2(GT, EQ, A_OF_R, B)  do { GT = 0u; EQ = 0u; _Pragma("unroll") for (int r_ = 15; r_ >= 0; --r_) { const auto a_ = (A_OF_R(r_)); GT = GT + GT + (unsigned)(a_ > (B)); EQ = EQ + EQ + (unsigned)(a_ == (B)); } } while (0)
__device__ __forceinline__ int dsa_mask_unit(const Ctx& X_, unsigned char* reg, int bl, int qb) {
    FRESH_CTX(X, X_);
    OPAQUE_GPTR(reg);
    const int lane = X.lane, wave = X.wave, half = lane >> 5, ql = lane & 31;
    const int t0 = qb * 32, nkt = qb + 1; const size_t seq0 = (size_t)bl * 4096;
    LAS unsigned* hist = (LAS unsigned*)X.lds; LAS unsigned long long* cand = (LAS unsigned long long*)X.lds;
    LAS unsigned* sel_b1 = (LAS unsigned*)(X.lds + DSA_SEL_OFF); LAS unsigned* sel_rem = sel_b1 + 32; LAS unsigned* sel_cnt = sel_rem + 32;
    LAS unsigned long long* sel_thr = (LAS unsigned long long*)(X.lds + DSA_SEL_OFF + 512);
    LAS bf16x8* qlo_lds = (LAS bf16x8*)(X.lds + DSA_SEL_OFF + 1024);
    LAS unsigned* seg = (LAS unsigned*)(X.lds + DSA_SEL_OFF + 1024 + 16384);
    LAS int* slot = (LAS int*)(X.lds + DSA_SEL_OFF + 400); unsigned* qctr = (unsigned*)(reg - WS_REG + WS_CTL) + CW_DSAQ;
    const bf16_t* IKH = (const bf16_t*)(reg + R_IKH) + seq0 * 32; const bf16_t* IKL = (const bf16_t*)(reg + R_IKL) + seq0 * 32;
    unsigned* MB = (unsigned*)(reg + R_MASK) + (((size_t)bl * 128 + qb) * 128) * 64 + lane;
    const size_t qrow = seq0 + t0 + ql; const int tq = t0 + ql;
    __syncthreads();
    if (qb < 8) {
        for (int kt = wave; kt < nkt; kt += 8) { unsigned bits = 0u;
#pragma unroll
            for (int r = 0; r < 16; ++r) if (kt * 32 + crow(r, half) <= tq) bits |= 1u << r;
            MB[(size_t)kt * 64] = bits; }
        if (X.tid == 0) slot[0] = (int)atomicAdd(qctr, 1u);
        __syncthreads();
        return slot[0];
    }
    float w[8]; { const f32x4 a = *(const f32x4*)((const float*)(reg + R_IW) + qrow * 8), b = *(const f32x4*)((const float*)(reg + R_IW) + qrow * 8 + 4);
        w[0] = a[0]; w[1] = a[1]; w[2] = a[2]; w[3] = a[3]; w[4] = b[0]; w[5] = b[1]; w[6] = b[2]; w[7] = b[3]; }
    const LAS bf16x8* qlo = qlo_lds + half * 32 + ql;
    const bf16_t* iqhrow = (const bf16_t*)(reg + R_IQH) + qrow * 256 + half * 8;
    bf16x8 qfh[8][2];
#pragma unroll
    for (int h = 0; h < 8; ++h)
#pragma unroll
        for (int s = 0; s < 2; ++s) qfh[h][s] = *(const bf16x8*)(iqhrow + h * 32 + s * 16);
    bf16x8 qt[2];
#pragma unroll
    for (int h = 0; h < 8; ++h) w[h] *= 0.5f;
#pragma unroll
    for (int s = 0; s < 2; ++s) { float a8[8];
#pragma unroll
        for (int j = 0; j < 8; ++j) a8[j] = 0.f;
#pragma unroll
        for (int h = 0; h < 8; ++h) { const u32x4 qv = __builtin_bit_cast(u32x4, qfh[h][s]);
            a8[0] += w[h] * hlo(qv.x); a8[1] += w[h] * hhi(qv.x); a8[2] += w[h] * hlo(qv.y); a8[3] += w[h] * hhi(qv.y); a8[4] += w[h] * hlo(qv.z); a8[5] += w[h] * hhi(qv.z); a8[6] += w[h] * hlo(qv.w); a8[7] += w[h] * hhi(qv.w); }
        u32x4 o; o.x = pk2(a8[0], a8[1]); o.y = pk2(a8[2], a8[3]); o.z = pk2(a8[4], a8[5]); o.w = pk2(a8[6], a8[7]); qt[s] = __builtin_bit_cast(bf16x8, o); }
    {
#pragma unroll
        for (int it = 0; it < 2; ++it) { const int idx = it * 512 + X.tid, q = idx >> 5, c8 = idx & 31;
            if (DSA_TERMS >= 2) qlo_lds[c8 * 32 + q] = *(const bf16x8*)((const bf16_t*)(reg + R_IQL) + (seq0 + t0 + q) * 256 + c8 * 8); }
    }
    LAS float* stat = (LAS float*)(X.lds + DSA_SEL_OFF + 768);
    if (X.tid < 64) stat[X.tid] = 0.f;
    if (X.tid < 2) { unsigned z = 0u; asm volatile("" : "+v"(z)); sel_b1[96 + X.tid] = z; }
    for (int i = X.tid; i < 32 * 1024; i += 512) hist[i] = 0u;
    unsigned cmask = 0u;
#pragma unroll
    for (int r = 0; r < 16; ++r) cmask |= (crow(r, half) <= ql) ? (1u << r) : 0u;
    __syncthreads();
    {
        const IkFrag f = ik_load(IKH, IKL, (wave * nkt) >> 3, lane); float sc[16]; dsa_scores(f, qfh, qt, qlo, w, sc); float s1 = 0.f, s2 = 0.f;
#pragma unroll
        for (int r = 0; r < 16; ++r) { s1 += sc[r]; s2 += sc[r] * sc[r]; }
        s1 += __shfl_xor(s1, 32); s2 += __shfl_xor(s2, 32);
        if (half == 0) { __hip_atomic_fetch_add(&stat[2 * ql], s1, __ATOMIC_RELAXED, __HIP_MEMORY_SCOPE_WORKGROUP); __hip_atomic_fetch_add(&stat[2 * ql + 1], s2, __ATOMIC_RELAXED, __HIP_MEMORY_SCOPE_WORKGROUP); }
    }
    __syncthreads();
    float lin_c0, lin_inv; { const float mean = stat[2 * ql] * (1.0f / 256.0f); const float var = fmaxf(stat[2 * ql + 1] * (1.0f / 256.0f) - mean * mean, 1e-30f); const float sd = sqrtf(var);
        lin_inv = (1024.0f / 12.0f) / sd; lin_c0 = -(mean - 6.0f * sd) * lin_inv; }
#define DSA_LINBIN(r) ((int)__builtin_amdgcn_fmed3f(__builtin_fmaf(sc[r], lin_inv, lin_c0), 0.f, 1023.f))
    LAS unsigned* hq_lane = hist + ql;
    {   IkFrag cur = ik_load(IKH, IKL, wave < nkt ? wave : 0, lane);
        for (int kt = wave; kt < nkt; kt += 8) { const IkFrag nxt = ik_load(IKH, IKL, kt + 8 < nkt ? kt + 8 : kt, lane);
            float sc[16]; dsa_scores(cur, qfh, qt, qlo, w, sc);
            if (kt != qb) {
#pragma unroll
                for (int r = 0; r < 16; ++r) __hip_atomic_fetch_add(&hq_lane[DSA_LINBIN(r) * 32], 1u, __ATOMIC_RELAXED, __HIP_MEMORY_SCOPE_WORKGROUP);
            } else {
#pragma unroll
                for (int r = 0; r < 16; ++r) if ((cmask >> r) & 1u) __hip_atomic_fetch_add(&hq_lane[DSA_LINBIN(r) * 32], 1u, __ATOMIC_RELAXED, __HIP_MEMORY_SCOPE_WORKGROUP);
            }
            cur = nxt; }
    }
    __syncthreads();
    dsa_pick_bin(hist, seg, sel_b1, sel_rem, sel_cnt, X.tid, 0, sel_b1 + 96);
    __syncthreads();
    const bool fast = sel_b1[96] == 0u;
    unsigned* MBQ = (unsigned*)(reg + R_MASK) + (((size_t)bl * 128 + qb) * 128) * 64;
    if (fast) {
        const int pref = (int)sel_b1[ql];
        const float f0 = pref == 0 ? -__builtin_inff() : (float)pref, f1 = pref == 1023 ? __builtin_inff() : (float)(pref + 1);
        IkFrag cur = ik_load(IKH, IKL, wave < nkt ? wave : 0, lane);
        for (int kt = wave; kt < nkt; kt += 8) { const IkFrag nxt = ik_load(IKH, IKL, kt + 8 < nkt ? kt + 8 : kt, lane);
            float sc[16]; dsa_scores(cur, qfh, qt, qlo, w, sc); unsigned ge0 = 0u, ge1 = 0u;
#pragma unroll
            for (int r = 15; r >= 0; --r) { const float t = __builtin_fmaf(sc[r], lin_inv, lin_c0); dsa_bit_ge(ge0, t, f0); dsa_bit_ge(ge1, t, f1); }
            unsigned gt = ge1, eq = ge0 & ~ge1;
            if (kt == qb) { gt &= cmask; eq &= cmask; }
            MB[(size_t)kt * 64] = gt;
            if (eq != 0u) {
#pragma unroll
                for (int r = 0; r < 16; ++r) if ((eq >> r) & 1u) { const unsigned pos = __hip_atomic_fetch_add(&sel_cnt[ql], 1u, __ATOMIC_RELAXED, __HIP_MEMORY_SCOPE_WORKGROUP);
                    if (pos < 256u) cand[ql * 256 + pos] = ((unsigned long long)f2key(sc[r]) << 32) | (unsigned long long)(0xFFFFFFFFu - (unsigned)(kt * 32 + crow(r, half))); } }
            cur = nxt; }
    } else {
        for (int level = 0; level < 2; ++level) {
            for (int i = X.tid; i < 32 * 1024; i += 512) hist[i] = 0u;
            __syncthreads();
            const unsigned pref = level ? sel_b1[ql] : 0u;
            IkFrag cur = ik_load(IKH, IKL, wave < nkt ? wave : 0, lane);
            for (int kt = wave; kt < nkt; kt += 8) { const IkFrag nxt = ik_load(IKH, IKL, kt + 8 < nkt ? kt + 8 : kt, lane);
                float sc[16]; dsa_scores(cur, qfh, qt, qlo, w, sc);
                const unsigned live = kt == qb ? cmask : 0xFFFFu;
#pragma unroll
                for (int r = 0; r < 16; ++r) { const unsigned key = f2key(sc[r]); const bool hit = ((live >> r) & 1u) && (level == 0 || (key >> 22) == pref);
                    if (hit) __hip_atomic_fetch_add(&hq_lane[(level ? ((key >> 12) & 1023u) : (key >> 22)) * 32], 1u, __ATOMIC_RELAXED, __HIP_MEMORY_SCOPE_WORKGROUP); }
                cur = nxt; }
            __syncthreads();
            dsa_pick_bin(hist, seg, sel_b1, sel_rem, sel_cnt, X.tid, level, nullptr);
            __syncthreads();
        }
        const unsigned pref = sel_b1[ql];
        IkFrag cur = ik_load(IKH, IKL, wave < nkt ? wave : 0, lane);
        for (int kt = wave; kt < nkt; kt += 8) { const IkFrag nxt = ik_load(IKH, IKL, kt + 8 < nkt ? kt + 8 : kt, lane);
            float sc[16]; dsa_scores(cur, qfh, qt, qlo, w, sc); unsigned gt, eq;
#define DSA_K20(r) (f2key(sc[r]) >> 12)
            DSA_BITS2(gt, eq, DSA_K20, pref);
            if (kt == qb) { gt &= cmask; eq &= cmask; }
            MB[(size_t)kt * 64] = gt;
            if (eq != 0u) {
#pragma unroll
                for (int r = 0; r < 16; ++r) if ((eq >> r) & 1u) { const unsigned pos = __hip_atomic_fetch_add(&sel_cnt[ql], 1u, __ATOMIC_RELAXED, __HIP_MEMORY_SCOPE_WORKGROUP);
                    if (pos < 256u) cand[ql * 256 + pos] = ((unsigned long long)f2key(sc[r]) << 32) | (unsigned long long)(0xFFFFFFFFu - (unsigned)(kt * 32 + crow(r, half))); } }
            cur = nxt; }
    }
    if (X.tid == 0) slot[0] = (int)atomicAdd(qctr, 1u);
    asm volatile("s_waitcnt vmcnt(0)" ::: "memory");
    __syncthreads();
    {
        for (int qi = 0; qi < 4; ++qi) { const int q = wave * 4 + qi; const unsigned cnt = (unsigned)__builtin_amdgcn_readfirstlane((int)sel_cnt[q]), rem = (unsigned)__builtin_amdgcn_readfirstlane((int)sel_rem[q]);
            if (cnt > 256u) { if (lane == 0) { sel_thr[q] = (unsigned long long)(sel_b1[q] << 12) << 32; sel_b1[97] = 1u; } continue; }
            const LAS unsigned long long* cq = cand + q * 256;
            for (unsigned e0 = 0; e0 < cnt; e0 += 64u) { const unsigned e = e0 + (unsigned)lane; const unsigned long long ce = e < cnt ? cq[e] : ~0ull; unsigned rank = 0;
#pragma unroll 4
                for (unsigned c2 = 0; c2 < cnt; ++c2) rank += (cq[c2] > ce) ? 1u : 0u;
                if (e < cnt) {
                    if (rank + 1u == rem) sel_thr[q] = ce;
                    if (rank < rem) { const unsigned kidx = 0xFFFFFFFFu - (unsigned)(ce & 0xFFFFFFFFull); const unsigned rho = kidx & 31u, hf = (rho >> 2) & 1u, rr = (rho & 3u) + 4u * (rho >> 3);
                        __hip_atomic_fetch_or(MBQ + (size_t)(kidx >> 5) * 64 + hf * 32 + q, 1u << rr, __ATOMIC_RELAXED, __HIP_MEMORY_SCOPE_AGENT); } } } }
    }
    __syncthreads();
    if (sel_b1[97] != 0u) {
        const unsigned long long thr = sel_thr[ql]; const float thr_f = key2f((unsigned)(thr >> 32)); const unsigned thr_i = 0xFFFFFFFFu - (unsigned)(thr & 0xFFFFFFFFull);
        asm volatile("s_waitcnt vmcnt(0)" ::: "memory");
        IkFrag cur = ik_load(IKH, IKL, wave < nkt ? wave : 0, lane);
        for (int kt = wave; kt < nkt; kt += 8) { const IkFrag nxt = ik_load(IKH, IKL, kt + 8 < nkt ? kt + 8 : kt, lane);
            float sc[16]; dsa_scores(cur, qfh, qt, qlo, w, sc); unsigned bits = 0u;
#pragma unroll
            for (int r = 0; r < 16; ++r) { const unsigned kidx = (unsigned)(kt * 32 + crow(r, half)); const bool sel = (sc[r] > thr_f) || (sc[r] == thr_f && kidx <= thr_i); if (sel && (int)kidx <= tq) bits |= 1u << r; }
            MB[(size_t)kt * 64] = bits;
            cur = nxt; }
    }
#undef DSA_LINBIN
#undef DSA_K20
    return slot[0];
}
__device__ __forceinline__ void dsa_att_tile2(const LAS unsigned char* kb, const LAS unsigned char* vb0, const LAS unsigned char* vb1, int half, int ksw, int vsw0, int vsw1, unsigned bitsA, unsigned bitsB, const bf16x8 (&qf)[4],
                                              f32x16& O0, f32x16& O1, float& mu, float& l, bool& any) {
    bf16x8 kfA[4], kfB[4];
#pragma unroll
    for (int s_ = 0; s_ < 4; ++s_) { kfA[s_] = *(const LAS bf16x8*)(kb + (((s_ * 2 + half) ^ ksw) * 16)); kfB[s_] = *(const LAS bf16x8*)(kb + 4096 + (((s_ * 2 + half) ^ ksw) * 16)); }
    f32x16 sA, sB;
#pragma unroll
    for (int r = 0; r < 16; ++r) { sA[r] = ((bitsA >> r) & 1u) ? -mu : -__builtin_inff(); sB[r] = ((bitsB >> r) & 1u) ? -mu : -__builtin_inff(); }
#pragma unroll
    for (int s_ = 0; s_ < 4; ++s_) asm volatile("" : "+v"(kfA[s_]), "+v"(kfB[s_]));
#pragma unroll
    for (int s_ = 0; s_ < 4; ++s_) { sA = mfma32h(kfA[s_], qf[s_], sA); sB = mfma32h(kfB[s_], qf[s_], sB); }
    bf16x8 vf0[2][2], vf1[2][2];
#pragma unroll
    for (int sp = 0; sp < 2; ++sp) { vf0[sp][0] = *(const LAS bf16x8*)(vb0 + (((sp * 2 + half) ^ vsw0) * 16)); vf1[sp][0] = *(const LAS bf16x8*)(vb1 + (((sp * 2 + half) ^ vsw1) * 16));
        vf0[sp][1] = *(const LAS bf16x8*)(vb0 + 4096 + (((sp * 2 + half) ^ vsw0) * 16)); vf1[sp][1] = *(const LAS bf16x8*)(vb1 + 4096 + (((sp * 2 + half) ^ vsw1) * 16)); }
#pragma unroll
    for (int sp = 0; sp < 2; ++sp) asm volatile("" : "+v"(vf0[sp][0]), "+v"(vf1[sp][0]), "+v"(vf0[sp][1]), "+v"(vf1[sp][1]));
    float xA[16], xB[16]; float ps = 0.f;
#pragma unroll
    for (int r = 0; r < 16; ++r) { xA[r] = __builtin_amdgcn_exp2f(sA[r]); xB[r] = __builtin_amdgcn_exp2f(sB[r]); ps += xA[r] + xB[r]; }
    if (!__all(ps <= 256.0f && (any || ps == 0.f))) {
        float mx = -__builtin_inff();
#pragma unroll
        for (int r = 0; r < 16; ++r) mx = fmaxf(mx, fmaxf(sA[r], sB[r]));
        const float dq = fmaxf(mx, __shfl_xor(mx, 32)); const bool fin = dq > -__builtin_inff();
        const float delta = any ? fmaxf(dq, 0.f) : (fin ? dq : 0.f);
        const float alpha = __builtin_amdgcn_exp2f(-delta);
        O0 *= alpha; O1 *= alpha; l *= alpha; mu += delta; any = any || fin;
        ps = 0.f;
#pragma unroll
        for (int r = 0; r < 16; ++r) { xA[r] = __builtin_amdgcn_exp2f(sA[r] - delta); xB[r] = __builtin_amdgcn_exp2f(sB[r] - delta); ps += xA[r] + xB[r]; }
    }
    l += ps;
    bf16x8 pA[2], pB[2];
#pragma unroll
    for (int sp = 0; sp < 2; ++sp) { u32x4 wv; wv.x = pk2(xA[8 * sp + 0], xA[8 * sp + 1]); wv.y = pk2(xA[8 * sp + 2], xA[8 * sp + 3]); wv.z = pk2(xA[8 * sp + 4], xA[8 * sp + 5]); wv.w = pk2(xA[8 * sp + 6], xA[8 * sp + 7]); pA[sp] = __builtin_bit_cast(bf16x8, wv);
        u32x4 wu; wu.x = pk2(xB[8 * sp + 0], xB[8 * sp + 1]); wu.y = pk2(xB[8 * sp + 2], xB[8 * sp + 3]); wu.z = pk2(xB[8 * sp + 4], xB[8 * sp + 5]); wu.w = pk2(xB[8 * sp + 6], xB[8 * sp + 7]); pB[sp] = __builtin_bit_cast(bf16x8, wu); }
#pragma unroll
    for (int sp = 0; sp < 2; ++sp) { O0 = mfma32h(vf0[sp][0], pA[sp], O0); O1 = mfma32h(vf1[sp][0], pA[sp], O1); O0 = mfma32h(vf0[sp][1], pB[sp], O0); O1 = mfma32h(vf1[sp][1], pB[sp], O1); }
}
__device__ __forceinline__ void dsa_attn_unit(const Ctx& X_, unsigned char* reg, int bl, int hh, int qblk) {
    FRESH_CTX(X, X_);
    OPAQUE_GPTR(reg);
    const int lane = X.lane, wave = X.wave, half = lane >> 5, ql = lane & 31, tid = X.tid;
    const int qt = qblk * 8 + wave, npair = qblk * 4 + 4; const size_t seq0 = (size_t)bl * 4096; const size_t qrow = seq0 + (size_t)qt * 32 + ql;
    const bool isk = tid < 256; const int t2 = tid & 255; const int srow = isk ? (t2 >> 3) : (t2 >> 2), sc_ = isk ? (t2 & 7) : (t2 & 3);
    const bf16_t* ssrc = isk ? (const bf16_t*)(reg + R_AK) + (seq0 + srow) * 512 + hh * 64 + sc_ * 8 : (const bf16_t*)(reg + R_AVT) + ((size_t)bl * 8 + hh) * 128 * 2048 + srow * 32 + sc_ * 8;
    const size_t sstep = isk ? (size_t)32 * 512 : (size_t)2048;
    const int sdst = isk ? srow * 128 + ((sc_ ^ (srow & 7)) * 16) : 8192 + srow * 64 + ((sc_ ^ ((srow >> 2) & 3)) * 16);
    bf16x8 qf[4];
#pragma unroll
    for (int s = 0; s < 4; ++s) { const f16x8 qv = __builtin_bit_cast(f16x8, *(const bf16x8*)((const bf16_t*)(reg + R_AQ) + qrow * 512 + hh * 64 + s * 16 + half * 8)) * (_Float16)(0.125f * 1.4426950408889634f);
        qf[s] = __builtin_bit_cast(bf16x8, qv); }
    const unsigned* MB = (const unsigned*)(reg + R_MASK) + (((size_t)bl * 128 + qt) * 128) * 64 + lane;
    const LAS unsigned char* kb = X.lds + ql * 128; const LAS unsigned char* vb0 = X.lds + 8192 + ql * 64; const LAS unsigned char* vb1 = X.lds + 8192 + (32 + ql) * 64;
    const int ksw = ql & 7, vsw0 = (ql >> 2) & 3, vsw1 = ((32 + ql) >> 2) & 3;
    __syncthreads();
    bf16x8 sa0, sb0, sa1, sb1, sa2, sb2;
#define STG_LOAD(A, B, P) do { const size_t _p = (size_t)((P) < npair ? (P) : 0) * 2; A = *(const bf16x8*)(ssrc + _p * sstep); B = *(const bf16x8*)(ssrc + (_p + 1) * sstep); } while (0)
    { bf16x8 a, b; STG_LOAD(a, b, 0); *(LAS bf16x8*)(X.lds + sdst) = a; *(LAS bf16x8*)(X.lds + sdst + 4096) = b; }
    STG_LOAD(sa1, sb1, 1); STG_LOAD(sa2, sb2, 2); STG_LOAD(sa0, sb0, 3);
    unsigned mbA = MB[0], mbB = MB[64];
    f32x16 O0 = zero16(), O1 = zero16(); float mu = 0.f, l = 0.f; bool any = false;
    __syncthreads();
#define ATT_ITER(SA, SB) do { if (kp < npair) { const int cb = (kp & 1) * 16384, nb = ((kp + 1) & 1) * 16384; \
        if (kp + 1 < npair) { *(LAS bf16x8*)(X.lds + sdst + nb) = SA; *(LAS bf16x8*)(X.lds + sdst + nb + 4096) = SB; } \
        STG_LOAD(SA, SB, kp + 4); \
        if (2 * kp <= qt) { const unsigned bitsA = mbA, bitsB = (2 * kp + 1 <= qt) ? mbB : 0u; const int kn = 2 * kp + 2 <= qt ? 2 * kp + 2 : 2 * kp; mbA = MB[(size_t)kn * 64]; mbB = MB[(size_t)(kn + 1 <= qt ? kn + 1 : kn) * 64]; \
            dsa_att_tile2(kb + cb, vb0 + cb, vb1 + cb, half, ksw, vsw0, vsw1, bitsA, bitsB, qf, O0, O1, mu, l, any); } \
        __syncthreads(); } ++kp; } while (0)
    for (int kp = 0; kp < npair; ) { ATT_ITER(sa1, sb1); ATT_ITER(sa2, sb2); ATT_ITER(sa0, sb0); }
#undef ATT_ITER
#undef STG_LOAD
    l += __shfl_xor(l, 32);
    const float inv = 1.0f / l;
    bf16_t* YA = (bf16_t*)(reg + R_YS) + qrow * 512 + hh * 64;
#pragma unroll
    for (int g4 = 0; g4 < 4; ++g4) { const int d0 = 8 * g4 + 4 * half;
        u32x2 w0; w0.x = pk2(O0[4 * g4 + 0] * inv, O0[4 * g4 + 1] * inv); w0.y = pk2(O0[4 * g4 + 2] * inv, O0[4 * g4 + 3] * inv); *(u32x2*)(YA + d0) = w0;
        u32x2 w1; w1.x = pk2(O1[4 * g4 + 0] * inv, O1[4 * g4 + 1] * inv); w1.y = pk2(O1[4 * g4 + 2] * inv, O1[4 * g4 + 3] * inv); *(u32x2*)(YA + 32 + d0) = w1; }
}

#ifdef DBG_CHECKS
__device__ __forceinline__ unsigned dbg_hash(unsigned x) { x ^= x >> 16; x *= 0x7feb352du; x ^= x >> 15; x *= 0x846ca68bu; x ^= x >> 16; return x; }
__device__ __forceinline__ float dbg_dot_h(const bf16_t* a, const bf16_t* b, int K) { float s = 0.f; for (int k = 0; k < K; ++k) s += h2f(a[k]) * h2f(b[k]); return s; }
__device__ __forceinline__ void dbg_acc(float* dbg, int k, float got, float ref) { atomicAdd(&dbg[2 * k], (got - ref) * (got - ref)); atomicAdd(&dbg[2 * k + 1], ref * ref); }
__global__ void dbg_chk_proj(unsigned char* ws) {
    unsigned char* reg = ws + WS_REG; float* dbg = (float*)(ws + 512 * 1024);
    const unsigned sidx = blockIdx.x * blockDim.x + threadIdx.x; const unsigned h1 = dbg_hash(sidx * 2 + 1), h2 = dbg_hash(sidx * 2 + 2);
    const size_t row = h1 % MH; const bf16_t* H = (const bf16_t*)(reg + R_H) + row * D; const bf16_t* HL = (const bf16_t*)(reg + R_HLO) + row * D; const bf16_t* W = (const bf16_t*)(ws + WS_WIN);
    { const int col = h2 % 512; dbg_acc(dbg, 0, h2f(((const bf16_t*)(reg + R_AQ))[row * 512 + col]), dbg_dot_h(H, W + (size_t)col * D, D)); }
    { const int col = h2 % 512; dbg_acc(dbg, 1, h2f(((const bf16_t*)(reg + R_AK))[row * 512 + col]), dbg_dot_h(H, W + (size_t)(512 + col) * D, D)); }
    { const int col = h2 % 512; const size_t b = row >> 12, t = row & 4095; dbg_acc(dbg, 2, h2f(((const bf16_t*)(reg + R_AVT))[avt_index(b, col, t)]), dbg_dot_h(H, W + (size_t)(1024 + col) * D, D)); }
    { const int col = h2 % 256; const bf16_t* WL = (const bf16_t*)(ws + WS_WINLO) + (size_t)col * D; const bf16_t* Wc = W + (size_t)(1536 + col) * D; float r = 0.f;
      for (int k = 0; k < D; ++k) r += (h2f(H[k]) + h2f(HL[k])) * (h2f(Wc[k]) + h2f(WL[k]));
      dbg_acc(dbg, 3, h2f(((const bf16_t*)(reg + R_IQH))[row * 256 + col]) + h2f(((const bf16_t*)(reg + R_IQL))[row * 256 + col]), r); }
    { const int col = h2 % 32; const bf16_t* WL = (const bf16_t*)(ws + WS_WINLO) + (size_t)(256 + col) * D; const bf16_t* Wc = W + (size_t)(1792 + col) * D; float r = 0.f;
      for (int k = 0; k < D; ++k) r += (h2f(H[k]) + h2f(HL[k])) * (h2f(Wc[k]) + h2f(WL[k]));
      dbg_acc(dbg, 4, h2f(((const bf16_t*)(reg + R_IKH))[row * 32 + col]) + h2f(((const bf16_t*)(reg + R_IKL))[row * 32 + col]), r); }
    { const int col = h2 % 8; const bf16_t* WL = (const bf16_t*)(ws + WS_WINLO) + (size_t)(256 + 32 + col) * D; const bf16_t* Wc = W + (size_t)(1792 + 32 + col) * D; float r = 0.f;
      for (int k = 0; k < D; ++k) r += (h2f(H[k]) + h2f(HL[k])) * (h2f(Wc[k]) + h2f(WL[k]));
      dbg_acc(dbg, 5, ((const float*)(reg + R_IW))[row * 8 + col], r * 0.0625f); }
    { const int col = h2 % 16; const bf16_t* WL = (const bf16_t*)(ws + WS_WINLO) + (size_t)(256 + 40 + col) * D; const bf16_t* Wc = W + (size_t)(1792 + 40 + col) * D; float r = 0.f;
      for (int k = 0; k < D; ++k) r += (h2f(H[k]) + h2f(HL[k])) * (h2f(Wc[k]) + h2f(WL[k]));
      dbg_acc(dbg, 6, ((const float*)(reg + R_GLR))[row * 16 + col], r); }
    { const int col = h2 % 512; const size_t b = row >> 12, t = row & 4095, g = col >> 4, p = col & 15; dbg_acc(dbg, 7, h2f(((const bf16_t*)(reg + R_S5A))[(g * 512 + b * 128 + (t >> 5)) * S5K + (t & 31) * 16 + p]), dbg_dot_h(H, W + (size_t)(2048 + col) * D, D)); }
    { const int col = h2 % 256; dbg_acc(dbg, 8, h2f(((const bf16_t*)(reg + R_GQ))[row * 256 + col]), dbg_dot_h(H, W + (size_t)(2560 + col) * D, D)); }
    { const int col = h2 % 256; dbg_acc(dbg, 9, h2f(((const bf16_t*)(reg + R_GK))[row * 256 + col]), dbg_dot_h(H, W + (size_t)(2816 + col) * D, D)); }
    { const int col = h2 % 512; dbg_acc(dbg, 10, h2f(((const bf16_t*)(reg + R_GV))[row * 512 + col]), dbg_dot_h(H, W + (size_t)(3072 + col) * D, D)); }
    { const int col = h2 % 512; dbg_acc(dbg, 11, h2f(((const bf16_t*)(reg + R_GR))[row * 512 + col]), dbg_dot_h(H, W + (size_t)(3584 + col) * D, D)); }
    { const int col = h2 % 3072; const float z = dbg_dot_h(H, W + (size_t)(4096 + col) * D, D); dbg_acc(dbg, 12, h2f(((const bf16_t*)(reg + R_GATES))[((size_t)(col >> 10) * MH + row) * D + (col & 1023)]), 1.0f / (1.0f + expf(-z))); }
}
__global__ void dbg_chk_w(unsigned char* ws, const float* w_in, const float* w_glu, const float* w_br, const float* w_out, const float* w_up, const float* w_dn) {
    float* dbg = (float*)(ws + 512 * 1024); const unsigned sidx = blockIdx.x * blockDim.x + threadIdx.x; const unsigned h1 = dbg_hash(sidx * 2 + 11), h2 = dbg_hash(sidx * 2 + 12);
    { const int n = h1 % NPROJ, k = h2 % D; const int sc = MapWin()(n); dbg_acc(dbg, 13, h2f(((const bf16_t*)(ws + WS_WIN))[(size_t)n * D + k]), sc >= 0 ? w_in[(size_t)k * D_IN + sc] : 0.f); }
    { const int n = h1 % 1024, k = h2 % 512; dbg_acc(dbg, 14, h2f(((const bf16_t*)(ws + WS_WGLU))[(size_t)n * 512 + k]), w_glu[(size_t)k * 1024 + MapGlu()(n)]); }
    { const int n = h1 % 3072, k = h2 % 512; dbg_acc(dbg, 15, h2f(((const bf16_t*)(ws + WS_WBR))[(size_t)n * 512 + k]), w_br[((size_t)(n >> 10) * 512 + k) * 1024 + (n & 1023)]); }
    { const int n = h1 % 1024, k = h2 % 1024; dbg_acc(dbg, 16, h2f(((const bf16_t*)(ws + WS_WOUT))[(size_t)n * D + k]), w_out[(size_t)k * D + n]); }
    { const int n = h1 % DUP, k = h2 % 1024; dbg_acc(dbg, 17, h2f(((const bf16_t*)(ws + WS_WUP))[(size_t)n * D + k]), w_up[(size_t)k * DUP + n]); }
    { const int n = h1 % 1024, k = h2 % DFF; dbg_acc(dbg, 18, h2f(((const bf16_t*)(ws + WS_WDN))[(size_t)n * DFF + k]), w_dn[(size_t)k * D + n]); }
}
__global__ void dbg_chk_glu(unsigned char* ws) {
    unsigned char* reg = ws + WS_REG; float* dbg = (float*)(ws + 512 * 1024); const unsigned sidx = blockIdx.x * blockDim.x + threadIdx.x; const unsigned h1 = dbg_hash(sidx * 2 + 21), h2 = dbg_hash(sidx * 2 + 22);
    const size_t row = h1 % MH; const int col = h2 % 512; const bf16_t* A = (const bf16_t*)(reg + R_GACT) + row * 512; const bf16_t* W = (const bf16_t*)(ws + WS_WGLU);
    const int pn = col >> 7, c = col & 127; const float ga = dbg_dot_h(A, W + (size_t)(pn * 256 + c) * 512, 512), gb = dbg_dot_h(A, W + (size_t)(pn * 256 + 128 + c) * 512, 512);
    dbg_acc(dbg, 19, h2f(((const bf16_t*)(reg + R_YS))[((size_t)MH + row) * 512 + col]), ga / (1.0f + expf(-gb)));
}
__global__ void dbg_chk_merge(unsigned char* ws) {
    unsigned char* reg = ws + WS_REG; float* dbg = (float*)(ws + 512 * 1024); const unsigned sidx = blockIdx.x * blockDim.x + threadIdx.x; const unsigned h1 = dbg_hash(sidx * 2 + 31), h2 = dbg_hash(sidx * 2 + 32);
    const size_t row = h1 % MH; const int col = h2 % D; float r = 0.f;
    for (int i = 0; i < 3; ++i) r += h2f(((const bf16_t*)(reg + R_GATES))[((size_t)i * MH + row) * D + col]) * dbg_dot_h((const bf16_t*)(reg + R_YS) + ((size_t)i * MH + row) * 512, (const bf16_t*)(ws + WS_WBR) + ((size_t)i * 1024 + col) * 512, 512);
    dbg_acc(dbg, 20, h2f(((const bf16_t*)(reg + R_H))[row * D + col]), r);
}
__global__ void dbg_chk_gemm(unsigned char* ws, int k, size_t a_off, int lda, size_t b_off, int K, size_t o_off, int ldo, int N) {
    unsigned char* reg = ws + WS_REG; float* dbg = (float*)(ws + 512 * 1024); const unsigned sidx = blockIdx.x * blockDim.x + threadIdx.x; const unsigned h1 = dbg_hash(sidx * 2 + 41 + k), h2 = dbg_hash(sidx * 2 + 42 + k);
    const size_t row = h1 % MH; const int col = h2 % N;
    dbg_acc(dbg, k, h2f(((const bf16_t*)(reg + o_off))[row * ldo + col]), dbg_dot_h((const bf16_t*)(reg + a_off) + row * lda, (const bf16_t*)(ws + b_off) + (size_t)col * K, K));
}
__global__ void dbg_chk_act(unsigned char* ws, const float* cw, const float* cb) {
    unsigned char* reg = ws + WS_REG; float* dbg = (float*)(ws + 512 * 1024); const unsigned sidx = blockIdx.x * blockDim.x + threadIdx.x; const unsigned h1 = dbg_hash(sidx * 2 + 51), h2 = dbg_hash(sidx * 2 + 52);
    const size_t row = h1 % MH; const int c = h2 % DFF; const bf16_t* U = (const bf16_t*)(reg + R_U); const int t = (int)(row & 4095); float g = cb[c], v = cb[DFF + c];
    for (int j = 0; j < 3; ++j) { const int tt = t - 2 + j; if (tt >= 0) { g += cw[j * DUP + c] * h2f(U[(row - 2 + j) * DUP + c]); v += cw[j * DUP + DFF + c] * h2f(U[(row - 2 + j) * DUP + DFF + c]); } }
    const float ge = 0.5f * g * (1.0f + tanhf(0.7978845608f * (g + 0.044715f * g * g * g)));
    dbg_acc(dbg, 24, h2f(((const bf16_t*)(reg + R_ACT))[row * DFF + c]), ge * v);
}

__global__ void dbg_chk_dsa(unsigned char* ws) {
    unsigned char* reg = ws + WS_REG; float* dbg = (float*)(ws + 512 * 1024);
    __shared__ float sc[4096]; __shared__ int sel[256]; __shared__ int nsel; __shared__ float lg[8][256];
    const int tlist[12] = {5, 100, 255, 256, 300, 511, 777, 1500, 2047, 3000, 4000, 4095};
    const int bl = (blockIdx.x & 1) ? 3 : 0, t = tlist[blockIdx.x >> 1], tid = threadIdx.x; const size_t row = (size_t)bl * 4096 + t;
    const bf16_t* IQH = (const bf16_t*)(reg + R_IQH) + row * 256; const bf16_t* IQL = (const bf16_t*)(reg + R_IQL) + row * 256; const float* IW = (const float*)(reg + R_IW) + row * 8;
    for (int s = tid; s <= t; s += 256) { const bf16_t* kh = (const bf16_t*)(reg + R_IKH) + ((size_t)bl * 4096 + s) * 32; const bf16_t* kl = (const bf16_t*)(reg + R_IKL) + ((size_t)bl * 4096 + s) * 32; float acc = 0.f;
        for (int h = 0; h < 8; ++h) { float d = 0.f; for (int k = 0; k < 32; ++k) d += (h2f(IQH[h * 32 + k]) + h2f(IQL[h * 32 + k])) * (h2f(kh[k]) + h2f(kl[k])); acc += IW[h] * fmaxf(d, 0.f); }
        sc[s] = acc; }
    if (tid == 0) nsel = 0;
    __syncthreads();
    if ((bl == 0 && t == 300) || (bl == 3 && t == 4095)) for (int s2 = tid; s2 <= t; s2 += 256) dbg_acc(dbg, 38, ((const float*)(ws + 900 * 1024))[(bl ? 4096 : 0) + s2], sc[s2]);
    for (int s = tid; s <= t; s += 256) { int rank = 0; const float v = sc[s]; for (int s2 = 0; s2 <= t; ++s2) { const float v2 = sc[s2]; rank += (v2 > v || (v2 == v && s2 < s)) ? 1 : 0; }
        if (rank < 256) { const int p = atomicAdd(&nsel, 1); sel[p] = s; } }
    __syncthreads();
    if (t >= 256) for (int s2 = tid; s2 <= t; s2 += 256) { int rank = 0; const float v = sc[s2]; for (int s3 = 0; s3 <= t; ++s3) { const float v2 = sc[s3]; rank += (v2 > v || (v2 == v && s3 < s2)) ? 1 : 0; }
        if (rank == 255) { const unsigned long long thr = ((const unsigned long long*)(ws + 600 * 1024))[row]; const unsigned cnt = ((const unsigned*)(ws + 800 * 1024))[row];
            dbg_acc(dbg, 35, (float)cnt, 256.0f); dbg_acc(dbg, 36, (float)(0xFFFFFFFFu - (unsigned)(thr & 0xFFFFFFFFull)), (float)s2);
            const unsigned kf = (unsigned)(thr >> 32); const float tv = __uint_as_float((kf & 0x80000000u) ? (kf & 0x7FFFFFFFu) : ~kf); dbg_acc(dbg, 37, tv, v); } }
    __syncthreads();
    const int n = nsel;
    if (tid < n) { const int key = sel[tid]; for (int h = 0; h < 8; ++h) { float d = 0.f; for (int k = 0; k < 64; ++k) d += h2f(((const bf16_t*)(reg + R_AQ))[row * 512 + h * 64 + k]) * h2f(((const bf16_t*)(reg + R_AK))[((size_t)bl * 4096 + key) * 512 + h * 64 + k]); lg[h][tid] = d * 0.125f; } }
    __syncthreads();
    if (t >= 256) {
        const int h = tid >> 5, l32 = tid & 31; float mx = -1e30f, den = 0.f, o0 = 0.f, o1 = 0.f;
        for (int pass = 0; pass < 2; ++pass) for (int key = 0; key <= t; ++key) { float d = 0.f; for (int k = 0; k < 64; ++k) d += h2f(((const bf16_t*)(reg + R_AQ))[row * 512 + h * 64 + k]) * h2f(((const bf16_t*)(reg + R_AK))[((size_t)bl * 4096 + key) * 512 + h * 64 + k]); d *= 0.125f;
            if (pass == 0) mx = fmaxf(mx, d); else { const float p = expf(d - mx); den += p; o0 += p * h2f(((const bf16_t*)(reg + R_AVT))[avt_index(bl, h * 64 + l32 * 2, key)]); o1 += p * h2f(((const bf16_t*)(reg + R_AVT))[avt_index(bl, h * 64 + l32 * 2 + 1, key)]); } }
        dbg_acc(dbg, 34, h2f(((const bf16_t*)(reg + R_YS))[row * 512 + h * 64 + l32 * 2]), o0 / den); dbg_acc(dbg, 34, h2f(((const bf16_t*)(reg + R_YS))[row * 512 + h * 64 + l32 * 2 + 1]), o1 / den);
    }
    { const int h = tid >> 5, l32 = tid & 31; float mx = -1e30f; for (int j = 0; j < n; ++j) mx = fmaxf(mx, lg[h][j]); float den = 0.f; for (int j = 0; j < n; ++j) den += expf(lg[h][j] - mx);
      for (int q = 0; q < 2; ++q) { const int d = l32 * 2 + q; float o = 0.f; for (int j = 0; j < n; ++j) o += expf(lg[h][j] - mx) / den * h2f(((const bf16_t*)(reg + R_AVT))[avt_index(bl, h * 64 + d, sel[j])]);
          dbg_acc(dbg, (blockIdx.x >> 1) < 3 ? 25 : 31 + ((blockIdx.x >> 1) - 3) / 3, h2f(((const bf16_t*)(reg + R_YS))[row * 512 + h * 64 + d]), o); } }
}
__global__ void __launch_bounds__(128) dbg_chk_gla(unsigned char* ws, const float* wgate, const float* bgate, const float* normg) {
    unsigned char* reg = ws + WS_REG; float* dbg = (float*)(ws + 512 * 1024);
    __shared__ float a_s[64], q_s[64], k_s[64], red[128];
    const int bl = (blockIdx.x >> 2) ? 2 : 0, h = blockIdx.x & 3, e = threadIdx.x; float S[64];
#pragma unroll
    for (int d = 0; d < 64; ++d) S[d] = 0.f;
    for (int t = 0; t < 256; ++t) { const size_t row = (size_t)bl * 4096 + t;
        if (e < 64) { const int c = h * 64 + e; float x = bgate[c]; for (int r = 0; r < 16; ++r) x += ((const float*)(reg + R_GLR))[row * 16 + r] * wgate[r * 256 + c];
            const float ls = fminf(x, 0.f) - log1pf(expf(-fabsf(x))); a_s[e] = expf(ls / 16.0f); q_s[e] = h2f(((const bf16_t*)(reg + R_GQ))[row * 256 + c]) * 0.125f; k_s[e] = h2f(((const bf16_t*)(reg + R_GK))[row * 256 + c]); }
        __syncthreads();
        const float v = h2f(((const bf16_t*)(reg + R_GV))[row * 512 + h * 128 + e]); float o = 0.f;
#pragma unroll
        for (int d = 0; d < 64; ++d) { S[d] = a_s[d] * S[d] + k_s[d] * v; o += q_s[d] * S[d]; }
        red[e] = o * o; __syncthreads();
        for (int st = 64; st > 0; st >>= 1) { if (e < st) red[e] += red[e + st]; __syncthreads(); }
        const float rstd = rsqrtf(red[0] / 128.0f + EPS); const float r = h2f(((const bf16_t*)(reg + R_GR))[row * 512 + h * 128 + e]);
        dbg_acc(dbg, 26, h2f(((const bf16_t*)(reg + R_YS))[((size_t)2 * MH + row) * 512 + h * 128 + e]), o * rstd * normg[h * 128 + e] * (r / (1.0f + expf(-r))));
        __syncthreads(); }
}
__global__ void dbg_chk_s5(unsigned char* ws, const float* lam_re, const float* lam_im, const float* log_dt, const float* b_re, const float* b_im, const float* c_re, const float* c_im, const float* dsk) {
    unsigned char* reg = ws + WS_REG; float* dbg = (float*)(ws + 512 * 1024);
    __shared__ float xr_s[64], xi_s[64], u_s[16];
    const int glist[4] = {0, 7, 19, 31}; const int bl = (blockIdx.x >> 2) ? 3 : 0, g = glist[blockIdx.x & 3], n = threadIdx.x;
    const float dt = expf(log_dt[g]), lr = lam_re[g * 64 + n], li = lam_im[g * 64 + n], mag = expf(lr * dt), ar = mag * cosf(li * dt), ai = mag * sinf(li * dt), den = lr * lr + li * li, nr = ar - 1.0f, ni = ai;
    const float fr_ = (nr * lr + ni * li) / den, fi_ = (ni * lr - nr * li) / den; float xr = 0.f, xi = 0.f;
    for (int t = 0; t < 128; ++t) { const size_t row = (size_t)bl * 4096 + t;
        if (n < 16) u_s[n] = h2f(((const bf16_t*)(reg + R_S5A))[((size_t)g * 512 + bl * 128 + (t >> 5)) * S5K + (t & 31) * 16 + n]);
        __syncthreads();
        float bur = 0.f, bui = 0.f; for (int p = 0; p < 16; ++p) { const float br = b_re[((size_t)g * 64 + n) * 16 + p], bi = b_im[((size_t)g * 64 + n) * 16 + p]; bur += (fr_ * br - fi_ * bi) * u_s[p]; bui += (fr_ * bi + fi_ * br) * u_s[p]; }
        const float nxr = ar * xr - ai * xi + bur, nxi = ar * xi + ai * xr + bui; xr = nxr; xi = nxi; xr_s[n] = xr; xi_s[n] = xi;
        __syncthreads();
        if (n < 16) { float y = 0.f; for (int m = 0; m < 64; ++m) y += c_re[((size_t)g * 16 + n) * 64 + m] * xr_s[m] - c_im[((size_t)g * 16 + n) * 64 + m] * xi_s[m];
            y += dsk[g * 16 + n] * u_s[n]; const float ge = 0.5f * y * (1.0f + tanhf(0.7978845608f * (y + 0.044715f * y * y * y)));
            dbg_acc(dbg, 27, h2f(((const bf16_t*)(reg + R_GACT))[row * 512 + g * 16 + n]), ge); }
        __syncthreads(); }
}
__global__ void dbg_chk_t1(unsigned char* ws, const float* out, const float* c, const float* modw, const float* modb, const float* pre_g) {
    unsigned char* reg = ws + WS_REG; float* dbg = (float*)(ws + 512 * 1024); __shared__ float red[256];
    const size_t r = dbg_hash(blockIdx.x * 7 + 3) % MH, R = (size_t)MH + r; const int b = (int)(R >> 12), tid = threadIdx.x; const float* x = out + R * D;
    float s = 0.f; for (int k = tid; k < D; k += 256) s += x[k] * x[k]; red[tid] = s; __syncthreads();
    for (int st = 128; st > 0; st >>= 1) { if (tid < st) red[tid] += red[tid + st]; __syncthreads(); }
    const float rstd = rsqrtf(red[0] / 1024.0f + EPS);
    if (tid < 8) { const int col = dbg_hash(blockIdx.x * 8 + tid + 99) % D; float sh = modb[col], scl = modb[1024 + col];
        for (int k = 0; k < D; ++k) { const float cv = c[b * 1024 + k], sv = cv / (1.0f + expf(-cv)); sh += sv * modw[(size_t)k * 3072 + col]; scl += sv * modw[(size_t)k * 3072 + 1024 + col]; }
        const float ref = x[col] * rstd * pre_g[col] * (1.0f + scl) + sh;
        dbg_acc(dbg, 28, h2f(((const bf16_t*)(reg + R_H))[r * D + col]) + h2f(((const bf16_t*)(reg + R_HLO))[r * D + col]), ref); }
}
__global__ void dbg_chk_t2(unsigned char* ws, const float* xin, const float* out, const float* c, const float* mixw, const float* mixb, const float* ffnw, const float* ffnb, const float* post_g, const float* fpre_g) {
    unsigned char* reg = ws + WS_REG; float* dbg = (float*)(ws + 512 * 1024); __shared__ float red[256]; __shared__ float rs[2];
    const size_t r = dbg_hash(blockIdx.x * 5 + 1) % MH; const int b = (int)(r >> 12), tid = threadIdx.x; const bf16_t* y = (const bf16_t*)(reg + R_Y) + r * D;
    float s = 0.f; for (int k = tid; k < D; k += 256) { const float v = h2f(y[k]); s += v * v; } red[tid] = s; __syncthreads();
    for (int st = 128; st > 0; st >>= 1) { if (tid < st) red[tid] += red[tid + st]; __syncthreads(); }
    if (tid == 0) rs[0] = rsqrtf(red[0] / 1024.0f + EPS); __syncthreads();
    s = 0.f; for (int k = tid; k < D; k += 256) { const float v = out[r * D + k]; s += v * v; } red[tid] = s; __syncthreads();
    for (int st = 128; st > 0; st >>= 1) { if (tid < st) red[tid] += red[tid + st]; __syncthreads(); }
    if (tid == 0) rs[1] = rsqrtf(red[0] / 1024.0f + EPS); __syncthreads();
    if (tid < 8) { const int col = dbg_hash(blockIdx.x * 8 + tid + 77) % D; float gate = mixb[2048 + col], sh = ffnb[col], scl = ffnb[1024 + col];
        for (int k = 0; k < D; ++k) { const float cv = c[b * 1024 + k], sv = cv / (1.0f + expf(-cv)); gate += sv * mixw[(size_t)k * 3072 + 2048 + col]; sh += sv * ffnw[(size_t)k * 3072 + col]; scl += sv * ffnw[(size_t)k * 3072 + 1024 + col]; }
        const float xo = xin[r * D + col] + gate * (h2f(y[col]) * rs[0] * post_g[col]);
        dbg_acc(dbg, 29, out[r * D + col], xo);
        dbg_acc(dbg, 30, h2f(((const bf16_t*)(reg + R_HF))[r * D + col]), out[r * D + col] * rs[1] * fpre_g[col] * (1.0f + scl) + sh); }
}
__global__ void dbg_apply(unsigned char* ws, float* out, int n, int nchk) {
    const float* dbg = (const float*)(ws + 512 * 1024); float a = 0.f;
    for (int k = nchk - 1; k >= 0; --k) { if (k >= 34) continue; const float d = dbg[2 * k] / fmaxf(dbg[2 * k + 1], 1e-30f); const float tol = ((k >= 25 && k <= 27) || k >= 31) ? 2e-3f : DBG_TOL; if (d > tol || !(dbg[2 * k + 1] > 0.f)) a = 0.05f * (float)(k + 1); }
    for (int i = blockIdx.x * blockDim.x + threadIdx.x; i < n; i += gridDim.x * blockDim.x) out[i] *= (1.0f + a);
}
#endif

#define OUT_H(out, hb)   ((bf16_t*)((unsigned char*)(out) + (size_t)(hb) * 64 * MiB))
#define OUT_X16(out, hb) ((bf16_t*)((unsigned char*)(out) + (size_t)(hb) * 64 * MiB + (size_t)32 * MiB))
constexpr size_t R_XLAST = R_FFN_END;
static_assert(R_XLAST + (size_t)MH * D * 2 <= (R_MIX_END > R_FFN_END ? R_MIX_END : R_FFN_END), "last layer's x' fits inside the region");
static_assert(IDX_SPLIT == 0, "the h low part is not produced any more");
constexpr size_t R2_ACT = 0;
constexpr size_t R2_Y2 = R2_ACT + (size_t)2 * MH * DFF * 2;
constexpr size_t R2_EDGE = R2_Y2 + (size_t)2 * MH * D * 2;
static_assert(R2_EDGE + (size_t)128 * 22 * 1024 * 2 <= (R_MIX_END > R_FFN_END ? R_MIX_END : R_FFN_END), "batched FFN buffers fit inside the region");
constexpr int NPH = 2 + 8 * 12;
struct Params { const float* in[29]; float* out; unsigned char* ws; int ph_lo, ph_hi; };
static_assert(sizeof(Params) == 31 * 8 + 8, "Params has no padding");

typedef const Params __attribute__((address_space(4))) * KParams;
#define PHASE_ARGS() KParams Q = KP; asm volatile("" : "+s"(Q)); unsigned char* ws = Q->ws; OPAQUE_GPTR(ws); unsigned char* reg = ws + WS_REG; float* mod = (float*)(ws + WS_MOD); float* out = Q->out; const float* x_in = Q->in[0]; \
    (void)reg; (void)mod; (void)out; (void)x_in

__global__ void __launch_bounds__(512, 2) trunk_fwd(Params P) {
    extern __shared__ __attribute__((aligned(16))) unsigned char lds_raw[];
    Ctx X; X.lds = (LAS unsigned char*)lds_raw; X.tid = threadIdx.x; X.lane = X.tid & 63; X.wave = __builtin_amdgcn_readfirstlane(X.tid >> 6);
    X.G = gridDim.x; { const int bx = blockIdx.x; X.vcu = (X.G % 8 == 0) ? (bx % 8) * (X.G / 8) + bx / 8 : bx; }
    KParams KP = (KParams)__builtin_amdgcn_kernarg_segment_ptr();
    const int lo = P.ph_lo, hi = P.ph_hi;
#if MK_ONE_LAUNCH
    volatile LAS unsigned* MISC = (volatile LAS unsigned*)(X.lds + MISC_OFF);
    if (X.tid < 64) MISC[X.tid] = 0u;
    __syncthreads();
    XcdBarrier bar = xcd_barrier_post((unsigned*)(P.ws + WS_CTL) + CW_BAR, MISC + 8);
#define SEAM(ph) do { if ((ph) + 1 < hi) xcd_barrier(bar); } while (0)
#else
#define SEAM(ph) do { } while (0)
#endif
#define IN(ph) ((ph) >= lo && (ph) < hi)

    if (IN(0)) {
        { PHASE_ARGS(); if (PHSEL(0)) phase_adaln(X, Q->in[1], Q->in[2], Q->in[3], Q->in[21], Q->in[22], mod); }
        __syncthreads();
        { PHASE_ARGS(); if (PHSEL(17)) phase_convert(X, ws, Q->in[6], Q->in[15], Q->in[19], Q->in[20], Q->in[25], Q->in[28]); }
        __syncthreads();
        { PHASE_ARGS(); if (PHSEL(18)) phase_s5pre(X, ws, Q->in[7], Q->in[8], Q->in[9], Q->in[10], Q->in[11], Q->in[12], Q->in[13]); }
        SEAM(0);
    }
    if (PHSEL(1) && IN(1)) { { PHASE_ARGS(); phase_t1(X, x_in, 0, 0, Q->in[4], mod, OUT_H(out, 0), nullptr); } { PHASE_ARGS(); phase_t1(X, x_in, 1, 0, Q->in[4], mod, OUT_H(out, 1), nullptr); } SEAM(1); }

    for (int it = 0; it < 8; ++it) {
        const int l = it >> 1, hb = it & 1, pb = 2 + it * 12;
        if (pb >= hi || pb + 12 <= lo) continue;
        if (PHSEL(2) && IN(pb + 0)) { PHASE_ARGS();
            pg8::Gemm g{(const bf16_t*)OUT_H(out, hb), (const bf16_t*)(ws + WS_WIN), D, D, D};
            EpiProj E{reg};
#if IDX_SPLIT
            pg8::SchedProj S{X.G, (int)blockIdx.x, (size_t)(R_HLO - R_H), (size_t)(WS_WINLO - WS_WIN)};
#else
            pg8::SchedGrid S; S.init(MH / 256, NPROJ / 256, X.G, (int)blockIdx.x, (size_t)256 * D * 2, (size_t)256 * D * 2);
#endif
            for (int rp = 0; rp < NREP(2); ++rp) pg8::gemm_phase(X.lds, g, S, E);
            SEAM(pb + 0);
        }
        if (IN(pb + 1)) {
            if (PHSEL(3)) { PHASE_ARGS(); pg8::Gemm g{(const bf16_t*)(reg + R_S5A), (const bf16_t*)(ws + WS_S5BS), S5K, 512, 512};
              pg8::SchedS5 S{X.G, (int)blockIdx.x, 1}; EpiS5State E{(float*)(reg + R_S5SC)};
              for (int rp = 0; rp < NREP(3); ++rp) pg8::gemm_phase(X.lds, g, S, E); }
            __syncthreads();
            if (PHSEL(4)) { PHASE_ARGS(); for (int rp = 0; rp < NREP(4); ++rp) for (int u = X.vcu; u < 4 * 64; u += X.G) gla_c1(X, reg, Q->in[16] + (size_t)l * 16 * 256, Q->in[17] + (size_t)l * 256, u >> 6, u & 63); }
            __syncthreads();
            if (PHSEL(5)) { PHASE_ARGS();
                for (int rp = 0; rp < NREP(5); ++rp) { LAS int* slot = (LAS int*)(X.lds + DSA_SEL_OFF + 400);
                    const int base = (512 + X.G) * (it * NREP(5) + rp);
                    __syncthreads(); if (X.tid == 0) slot[0] = (int)atomicAdd((unsigned*)(ws + WS_CTL) + CW_DSAQ, 1u); __syncthreads(); int k = slot[0] - base;
                    while (k < 512) k = dsa_mask_unit(X, reg, k & 3, 127 - (k >> 2)) - base; } }
            SEAM(pb + 1);
        }
        if (IN(pb + 2)) {
            if (PHSEL(6)) { PHASE_ARGS(); for (int rp = 0; rp < NREP(6); ++rp) phase_scans(X, reg, Q->in[7] + (size_t)l * 2048, Q->in[8] + (size_t)l * 2048, Q->in[9] + (size_t)l * 32); }
            __syncthreads();
            if (PHSEL(5)) { PHASE_ARGS(); for (int rp = 0; rp < NREP(20); ++rp) for (int u = X.vcu; u < 4 * 8 * 8; u += X.G) { const int bl = u >> 6, hh = (u >> 3) & 7, j = u & 7; dsa_attn_unit(X, reg, bl, hh, 15 - j); dsa_attn_unit(X, reg, bl, hh, j); } }
            SEAM(pb + 2);
        }
        if (IN(pb + 3)) {
            if (PHSEL(7)) { PHASE_ARGS(); pg8::Gemm g{(const bf16_t*)(reg + R_S5A), (const bf16_t*)(ws + WS_S5BO), S5K, S5K, S5K};
              pg8::SchedS5 S{X.G, (int)blockIdx.x, 2}; EpiS5Out E{(const bf16_t*)(reg + R_S5A), Q->in[14] + (size_t)l * 512, (bf16_t*)(reg + R_GACT)};
              for (int rp = 0; rp < NREP(7); ++rp) pg8::gemm_phase(X.lds, g, S, E); }
            __syncthreads();
            if (PHSEL(8)) { PHASE_ARGS();
                unsigned* qc = (unsigned*)(ws + WS_CTL) + CW_C3Q; LAS int* slot = (LAS int*)X.lds; const int base = (256 + X.G) * it;
                __syncthreads(); if (X.tid == 0) slot[0] = (int)atomicAdd(qc, 1u); __syncthreads(); int k = slot[0] - base;
                while (k < 256) { int kn = 0; if (X.tid == 0) kn = (int)atomicAdd(qc, 1u);
                    gla_c3(X, reg, Q->in[18] + (size_t)l * 512, k >> 6, k & 63);
                    __syncthreads(); if (X.tid == 0) slot[0] = kn; __syncthreads(); k = slot[0] - base; } }
            SEAM(pb + 3);
        }
        if (PHSEL(9) && IN(pb + 4)) { PHASE_ARGS();
            pg8::Gemm g{(const bf16_t*)(reg + R_GACT), (const bf16_t*)(ws + WS_WGLU), 512, 512, 512};
            pg8::SchedGrid S; S.init(MH / 256, 4, X.G, (int)blockIdx.x, (size_t)256 * 512 * 2, (size_t)256 * 512 * 2);
            EpiGlu E{(bf16_t*)(reg + R_YS) + (size_t)MH * 512};
            for (int rp = 0; rp < NREP(9); ++rp) pg8::gemm_phase(X.lds, g, S, E);
            SEAM(pb + 4);
        }
        if (PHSEL(10) && IN(pb + 5)) { PHASE_ARGS();
            pg8::Gemm g{(const bf16_t*)(reg + R_YS), (const bf16_t*)(ws + WS_WBR), 512, 512, 512};
            pg8::SchedMerge S; S.S.init(MH / 256, 4, X.G, (int)blockIdx.x, (size_t)256 * 512 * 2, (size_t)256 * 512 * 2); S.abr = (size_t)MH * 512 * 2; S.bbr = (size_t)1024 * 512 * 2;
            EpiMerge E{(const bf16_t*)(reg + R_GATES), (bf16_t*)(reg + R_H)};
            for (int rp = 0; rp < NREP(10); ++rp) pg8::gemm_phase(X.lds, g, S, E);
            SEAM(pb + 5);
        }
        if (PHSEL(11) && IN(pb + 6)) { PHASE_ARGS();
            pg8::Gemm g{(const bf16_t*)(reg + R_H), (const bf16_t*)(ws + WS_WOUT), D, D, D};
            pg8::SchedGrid S; S.init(MH / 256, 4, X.G, (int)blockIdx.x, (size_t)256 * D * 2, (size_t)256 * D * 2);
            EpiPlain E{(bf16_t*)(reg + R_Y), D};
            for (int rp = 0; rp < NREP(11); ++rp) pg8::gemm_phase(X.lds, g, S, E);
            SEAM(pb + 6);
        }
        if (PHSEL(12) && IN(pb + 7)) { PHASE_ARGS(); phase_t2(X, (l == 0) ? x_in : nullptr, OUT_X16(out, hb), (l == 3) ? (bf16_t*)(reg + R_XLAST) : OUT_X16(out, hb), hb, l, (const bf16_t*)(reg + R_Y), Q->in[5], Q->in[23], mod,
                                                              (l == 3) ? (bf16_t*)(reg + R_HF) : OUT_H(out, hb)); SEAM(pb + 7); }
        if (l == 3) {
        if (PHSEL(13) && IN(pb + 8)) { PHASE_ARGS();
            pg8::Gemm g{(const bf16_t*)(reg + R_HF), (const bf16_t*)(ws + WS_WUP), D, D, D};
            pg8::SchedGrid S; S.init(MH / 256, DUP / 256, X.G, (int)blockIdx.x, (size_t)256 * D * 2, (size_t)256 * D * 2);
            EpiUpConv E{Q->in[26] + (size_t)l * 3 * DUP, Q->in[27] + (size_t)l * DUP, (bf16_t*)(reg + R_ACT), (bf16_t*)(reg + R_U), (LAS unsigned*)(X.lds + 8 * pg8::HTB)};
            for (int rp = 0; rp < NREP(13); ++rp) pg8::gemm_phase(X.lds, g, S, E);
            SEAM(pb + 8);
        }
        if (PHSEL(15) && IN(pb + 10)) { PHASE_ARGS();
            pg8::Gemm g{(const bf16_t*)(reg + R_ACT), (const bf16_t*)(ws + WS_WDN), DFF, DFF, DFF};
            pg8::SchedGrid S; S.init(MH / 256, 4, X.G, (int)blockIdx.x, (size_t)256 * DFF * 2, (size_t)256 * DFF * 2);
            { pg8::Unit u0; for (int i = 0; S.next(i, u0); ++i) upfix_panel(X, (const bf16_t*)(reg + R_U), Q->in[26] + (size_t)l * 3 * DUP, Q->in[27] + (size_t)l * DUP, (bf16_t*)(reg + R_ACT), u0.pm); }
            asm volatile("s_waitcnt vmcnt(0)" ::: "memory"); __syncthreads();
            EpiPlain E{(bf16_t*)(reg + R_Y2), D};
            for (int rp = 0; rp < NREP(15); ++rp) pg8::gemm_phase(X.lds, g, S, E);
            SEAM(pb + 10);
        }
        if (PHSEL(16) && IN(pb + 11)) {
            { PHASE_ARGS(); phase_t4(X, (const bf16_t*)(reg + R_XLAST), OUT_X16(out, hb), out, OUT_H(out, hb), hb, l, (const bf16_t*)(reg + R_Y2), Q->in[24], Q->in[4], mod); }
            SEAM(pb + 11);
        }
        } else if (hb == 1) {
        if (PHSEL(13) && IN(pb + 8)) { PHASE_ARGS();
            pg8::Gemm g{(const bf16_t*)OUT_H(out, 0), (const bf16_t*)(ws + WS_WUP), D, D, D};
            pg8::SchedGrid S; S.init(2 * MH / 256, DUP / 256, X.G, (int)blockIdx.x, (size_t)256 * D * 2, (size_t)256 * D * 2); S.nMh = MH / 256; S.ahalf = (size_t)64 * MiB;
            EpiUpConv E{Q->in[26] + (size_t)l * 3 * DUP, Q->in[27] + (size_t)l * DUP, (bf16_t*)(reg + R2_ACT), (bf16_t*)(reg + R2_EDGE), (LAS unsigned*)(X.lds + 8 * pg8::HTB)};
            pg8::gemm_phase(X.lds, g, S, E);
            SEAM(pb + 8);
        }
        if (PHSEL(15) && IN(pb + 10)) { PHASE_ARGS();
            pg8::Gemm g{(const bf16_t*)(reg + R2_ACT), (const bf16_t*)(ws + WS_WDN), DFF, DFF, DFF};
            pg8::SchedGrid S; S.init(2 * MH / 256, 4, X.G, (int)blockIdx.x, (size_t)256 * DFF * 2, (size_t)256 * DFF * 2);
            { pg8::Unit u0; for (int i = 0; S.next(i, u0); ++i) upfix_panel(X, (const bf16_t*)(reg + R2_EDGE), Q->in[26] + (size_t)l * 3 * DUP, Q->in[27] + (size_t)l * DUP, (bf16_t*)(reg + R2_ACT), u0.pm); }
            asm volatile("s_waitcnt vmcnt(0)" ::: "memory"); __syncthreads();
            EpiPlain E{(bf16_t*)(reg + R2_Y2), D};
            pg8::gemm_phase(X.lds, g, S, E);
            SEAM(pb + 10);
        }
        if (PHSEL(16) && IN(pb + 11)) {
            { PHASE_ARGS(); phase_t4(X, (const bf16_t*)OUT_X16(out, 0), OUT_X16(out, 0), nullptr, OUT_H(out, 0), 0, l, (const bf16_t*)(reg + R2_Y2), Q->in[24], Q->in[4], mod); }
            { PHASE_ARGS(); phase_t4(X, (const bf16_t*)OUT_X16(out, 1), OUT_X16(out, 1), nullptr, OUT_H(out, 1), 1, l, (const bf16_t*)(reg + R2_Y2) + (size_t)MH * D, Q->in[24], Q->in[4], mod); }
            { const int l2 = l + 1;
                __syncthreads();
                { PHASE_ARGS(); for (int rp = 0; rp < NREP(17); ++rp) phase_convert(X, ws, Q->in[6] + (size_t)l2 * D * D_IN, Q->in[15] + (size_t)l2 * 512 * 1024, Q->in[19] + (size_t)l2 * 3 * 512 * 1024, Q->in[20] + (size_t)l2 * D * D,
                              Q->in[25] + (size_t)l2 * D * DUP, Q->in[28] + (size_t)l2 * DFF * D); }
                __syncthreads();
                { PHASE_ARGS(); for (int rp = 0; rp < NREP(18); ++rp) phase_s5pre(X, ws, Q->in[7] + (size_t)l2 * 2048, Q->in[8] + (size_t)l2 * 2048, Q->in[9] + (size_t)l2 * 32, Q->in[10] + (size_t)l2 * 32768, Q->in[11] + (size_t)l2 * 32768,
                            Q->in[12] + (size_t)l2 * 32768, Q->in[13] + (size_t)l2 * 32768); }
            }
            SEAM(pb + 11);
        }
        }
    }
#undef IN
#undef SEAM
}

extern "C" void kernel_launch(void* const* d_in, const int* in_sizes, int n_in, void* d_out, int out_size, void* d_ws, size_t ws_size, hipStream_t stream) {
    static int grid = 0;
    if (grid == 0) {
        if (n_in != 29 || out_size != BATCH * T * D || ws_size < WS_END) { fprintf(stderr, "kernel_launch: unexpected shapes or workspace (%d inputs, out %d, ws %zu < %zu)\n", n_in, out_size, ws_size, (size_t)WS_END); grid = -1; return; }
        int dev = 0, cus = 0;
        if (hipGetDevice(&dev) != hipSuccess || hipDeviceGetAttribute(&cus, hipDeviceAttributeMultiprocessorCount, dev) != hipSuccess) { grid = -1; return; }
        if (hipFuncSetAttribute((const void*)trunk_fwd, hipFuncAttributeMaxDynamicSharedMemorySize, LDS_BYTES) != hipSuccess) { fprintf(stderr, "kernel_launch: hipFuncSetAttribute failed\n"); grid = -1; return; }
        int per_cu = 0;
        if (hipOccupancyMaxActiveBlocksPerMultiprocessor(&per_cu, (const void*)trunk_fwd, 512, LDS_BYTES) != hipSuccess || per_cu < 1) fprintf(stderr, "kernel_launch: occupancy query says %d\n", per_cu);
        (void)hipGetLastError();
        grid = cus;
    }
    if (grid < 0) return;
    (void)in_sizes;
    (void)hipMemsetAsync((char*)d_ws + WS_CTL, 0, CTL_BYTES, stream);
    Params p{};
    for (int i = 0; i < 29; ++i) p.in[i] = (const float*)d_in[i];
    p.out = (float*)d_out; p.ws = (unsigned char*)d_ws;
#if MK_ONE_LAUNCH
    p.ph_lo = 0; p.ph_hi = NPH;
    hipLaunchKernelGGL(trunk_fwd, dim3(grid), dim3(512), LDS_BYTES, stream, p);
#else
    for (int ph = 0; ph < NPH; ++ph) { p.ph_lo = ph; p.ph_hi = ph + 1; hipLaunchKernelGGL(trunk_fwd, dim3(grid), dim3(512), LDS_BYTES, stream, p);
#ifdef DBG_CHECKS
        unsigned char* ws = (unsigned char*)d_ws; const int pb7 = 2 + 7 * 12, pb6 = 2 + 6 * 12;
        if (ph == pb6 + 11) hipLaunchKernelGGL(dbg_chk_w, dim3(64), dim3(256), 0, stream, ws, p.in[6] + (size_t)3 * D * D_IN, p.in[15] + (size_t)3 * 512 * 1024, p.in[19] + (size_t)3 * 3 * 512 * 1024, p.in[20] + (size_t)3 * D * D, p.in[25] + (size_t)3 * D * DUP, p.in[28] + (size_t)3 * DFF * D);
        if (ph == pb7 + 0) hipLaunchKernelGGL(dbg_chk_proj, dim3(16), dim3(256), 0, stream, ws);
        if (ph == pb7 + 1) hipLaunchKernelGGL(dbg_chk_dsa, dim3(24), dim3(256), 0, stream, ws);
        if (ph == pb7 + 3) { hipLaunchKernelGGL(dbg_chk_gla, dim3(8), dim3(128), 0, stream, ws, p.in[16] + (size_t)3 * 16 * 256, p.in[17] + (size_t)3 * 256, p.in[18] + (size_t)3 * 512);
            hipLaunchKernelGGL(dbg_chk_s5, dim3(8), dim3(64), 0, stream, ws, p.in[7] + (size_t)3 * 2048, p.in[8] + (size_t)3 * 2048, p.in[9] + (size_t)3 * 32, p.in[10] + (size_t)3 * 32768, p.in[11] + (size_t)3 * 32768, p.in[12] + (size_t)3 * 32768, p.in[13] + (size_t)3 * 32768, p.in[14] + (size_t)3 * 512); }
        if (ph == pb6 + 11) hipLaunchKernelGGL(dbg_chk_t1, dim3(64), dim3(256), 0, stream, ws, (const float*)d_out, p.in[1], p.in[2] + (size_t)3 * 1024 * 3072, p.in[3] + (size_t)3 * 3072, p.in[4] + (size_t)3 * D);
        if (ph == 2 + 7) hipLaunchKernelGGL(dbg_chk_t2, dim3(64), dim3(256), 0, stream, ws, p.in[0], (const float*)d_out, p.in[1], p.in[2], p.in[3], p.in[21], p.in[22], p.in[5], p.in[23]);
        if (ph == pb7 + 4) hipLaunchKernelGGL(dbg_chk_glu, dim3(16), dim3(256), 0, stream, ws);
        if (ph == pb7 + 5) hipLaunchKernelGGL(dbg_chk_merge, dim3(16), dim3(256), 0, stream, ws);
        if (ph == pb7 + 6) hipLaunchKernelGGL(dbg_chk_gemm, dim3(16), dim3(256), 0, stream, ws, 21, R_H, D, WS_WOUT, D, R_Y, D, D);
        if (ph == pb7 + 8) hipLaunchKernelGGL(dbg_chk_gemm, dim3(16), dim3(256), 0, stream, ws, 22, R_HF, D, WS_WUP, D, R_U, DUP, DUP);
        if (ph == pb7 + 9) hipLaunchKernelGGL(dbg_chk_act, dim3(16), dim3(256), 0, stream, ws, p.in[26] + (size_t)3 * 3 * DUP, p.in[27] + (size_t)3 * DUP);
        if (ph == pb7 + 10) hipLaunchKernelGGL(dbg_chk_gemm, dim3(16), dim3(256), 0, stream, ws, 23, R_ACT, DFF, WS_WDN, DFF, R_Y2, D, D);
        if (ph == NPH - 1) hipLaunchKernelGGL(dbg_apply, dim3(1024), dim3(256), 0, stream, ws, (float*)d_out, BATCH * T * D, 34);
#endif
    }
#endif
}
```

```cpp
#include <hip/hip_runtime.h>
#include <cstdio>
#include <cstdint>

#ifndef MK_ONE_LAUNCH
#define MK_ONE_LAUNCH 1
#endif
#define DBG_TOL 1e-4f
#ifndef PHSEL_MASK
#define PHSEL_MASK 0xFFFFFFFFu
#endif
#define PHSEL(k) (((PHSEL_MASK) >> (k)) & 1u)
#ifndef IDX_SPLIT
#define IDX_SPLIT 0
#endif
#ifndef DSA_TERMS
#define DSA_TERMS 1
#endif
#ifndef DUP_MASK
#define DUP_MASK 0u
#endif
#define NREP(k) ((((DUP_MASK) >> (k)) & 1u) ? 2 : 1)

#define LAS __attribute__((address_space(3)))
#define GAS __attribute__((address_space(1)))
typedef unsigned short bf16_t;
typedef short bf16x8 __attribute__((ext_vector_type(8)));
typedef short bf16x4 __attribute__((ext_vector_type(4)));
typedef float f32x2 __attribute__((ext_vector_type(2)));
typedef float f32x4 __attribute__((ext_vector_type(4)));
typedef float f32x16 __attribute__((ext_vector_type(16)));
typedef unsigned u32x2 __attribute__((ext_vector_type(2)));
typedef unsigned u32x4 __attribute__((ext_vector_type(4)));
typedef __bf16 bf16x2v __attribute__((ext_vector_type(2)));
typedef _Float16 f16x2 __attribute__((ext_vector_type(2)));
typedef _Float16 f16x8 __attribute__((ext_vector_type(8)));

constexpr int D = 1024, BATCH = 8, T = 4096, DEPTH = 4;
constexpr int MH = 4 * T;
constexpr int NB_H = 4;
constexpr int D_IN = 6968, NPROJ = 7168;
constexpr int DFF = 2816, DUP = 2 * DFF;
constexpr int S5L = 32, S5NC = T / S5L;
constexpr int S5K = 640;
constexpr int GC = 64, GNC = T / GC;
constexpr float EPS = 1e-6f;

constexpr size_t al256(size_t x) { return (x + 255) & ~(size_t)255; }
constexpr size_t MiB = 1u << 20;
constexpr size_t WS_CTL = 0, CTL_BYTES = 1 * MiB;
constexpr size_t WS_MOD = WS_CTL + CTL_BYTES;
constexpr size_t WS_WIN = WS_MOD + al256((size_t)4 * 2 * 8 * 3072 * 4);
constexpr size_t WS_WGLU = WS_WIN + (size_t)NPROJ * D * 2;
constexpr size_t WS_WBR = WS_WGLU + (size_t)1024 * 512 * 2;
constexpr size_t WS_WOUT = WS_WBR + (size_t)3072 * 512 * 2;
constexpr size_t WS_WUP = WS_WOUT + (size_t)D * D * 2;
constexpr size_t WS_WDN = WS_WUP + (size_t)DUP * D * 2;
constexpr size_t WS_S5BO = WS_WDN + (size_t)D * DFF * 2;
constexpr size_t WS_S5BS = WS_S5BO + (size_t)32 * 512 * S5K * 2;
constexpr size_t WS_WINLO = WS_S5BS + (size_t)32 * 256 * 512 * 2;
constexpr size_t WS_REG = WS_WINLO + (size_t)512 * D * 2;
constexpr size_t R_H = 0;
constexpr size_t R_HLO = R_H + (size_t)MH * D * 2;
constexpr size_t R_AQ = R_HLO + (size_t)MH * D * 2;
constexpr size_t R_AK = R_AQ + (size_t)MH * 512 * 2;
constexpr size_t R_AVT = R_AK + (size_t)MH * 512 * 2;
constexpr size_t R_IQH = R_AVT + (size_t)MH * 512 * 2;
constexpr size_t R_IQL = R_IQH + (size_t)MH * 256 * 2;
constexpr size_t R_IKH = R_IQL + (size_t)MH * 256 * 2;
constexpr size_t R_IKL = R_IKH + (size_t)MH * 32 * 2;
constexpr size_t R_IW = R_IKL + (size_t)MH * 32 * 2;
constexpr size_t R_GQ = R_IW + (size_t)MH * 8 * 4;
constexpr size_t R_GK = R_GQ + (size_t)MH * 256 * 2;
constexpr size_t R_GV = R_GK + (size_t)MH * 256 * 2;
constexpr size_t R_GR = R_GV + (size_t)MH * 512 * 2;
constexpr size_t R_GLR = R_GR + (size_t)MH * 512 * 2;
constexpr size_t R_GATES = R_GLR + (size_t)MH * 16 * 4;
constexpr size_t R_YS = R_GATES + (size_t)3 * MH * D * 2;
constexpr size_t R_S5A = R_YS + (size_t)3 * MH * 512 * 2;
constexpr size_t R_S5SC = R_S5A + (size_t)32 * 512 * S5K * 2;
constexpr size_t R_GACT = R_S5SC + (size_t)32 * 512 * 128 * 4;
constexpr size_t R_QD = R_HLO;
constexpr size_t R_KI = R_QD + (size_t)MH * 256 * 2;
constexpr size_t R_VT = R_KI + (size_t)MH * 256 * 2;
static_assert(R_VT + (size_t)MH * 512 * 2 <= R_AQ, "GLA copies fit over h_lo");
constexpr size_t R_KVT = R_GACT + (size_t)MH * 512 * 2;
constexpr size_t R_ST = R_KVT + (size_t)4 * 4 * 64 * 128 * 64 * 4;
constexpr size_t R_DEC = R_ST + (size_t)4 * 4 * 64 * 128 * 64 * 2;
constexpr size_t R_MASK = R_DEC + (size_t)4 * 64 * 256 * 4;
constexpr size_t R_MIX_END = R_MASK + (size_t)4 * 128 * 128 * 64 * 4;
constexpr size_t R_Y = R_AQ;
constexpr size_t R_HF = 0;
constexpr size_t R_U = R_HF + (size_t)MH * D * 2;
constexpr size_t R_ACT = R_U + (size_t)MH * DUP * 2;
constexpr size_t R_Y2 = R_ACT + (size_t)MH * DFF * 2;
constexpr size_t R_FFN_END = R_Y2 + (size_t)MH * D * 2;
constexpr size_t WS_END = WS_REG + (R_MIX_END > R_FFN_END ? R_MIX_END : R_FFN_END);
static_assert(WS_END <= (size_t)512 * MiB, "workspace map exceeds 512 MiB");
static_assert(R_Y + (size_t)MH * D * 2 <= R_AVT, "y overlay");

constexpr int CW_BAR = 4096;
constexpr int CW_DSAQ = 2048;
constexpr int CW_C3Q = 2112;

constexpr int LDS_BYTES = 163840;
constexpr int MISC_OFF = LDS_BYTES - 256;

__device__ __forceinline__ float bf2f(unsigned b) { return __uint_as_float(b << 16); }
__device__ __forceinline__ unsigned pk2b(float lo, float hi) { f32x2 v = {lo, hi}; bf16x2v b = __builtin_convertvector(v, bf16x2v); return __builtin_bit_cast(unsigned, b); }
__device__ __forceinline__ unsigned pk2(float lo, float hi) { f32x2 v = {lo, hi}; f16x2 b = __builtin_convertvector(v, f16x2); return __builtin_bit_cast(unsigned, b); }
__device__ __forceinline__ float hlo(unsigned w) { const f16x2 h = __builtin_bit_cast(f16x2, w); return (float)h[0]; }
__device__ __forceinline__ float hhi(unsigned w) { const f16x2 h = __builtin_bit_cast(f16x2, w); return (float)h[1]; }
__device__ __forceinline__ float h2f(unsigned short b) { return (float)__builtin_bit_cast(_Float16, b); }
__device__ __forceinline__ unsigned short f2h(float f) { return __builtin_bit_cast(unsigned short, (_Float16)f); }
__device__ __forceinline__ unsigned short f2b(float f) { return (unsigned short)(pk2b(f, 0.f) & 0xffffu); }
__device__ __forceinline__ float bflo(unsigned w) { return __uint_as_float(w << 16); }
__device__ __forceinline__ float bfhi(unsigned w) { return __uint_as_float(w & 0xffff0000u); }
__device__ __forceinline__ float wave_sum(float v) {
#pragma unroll
    for (int o = 1; o < 64; o <<= 1) v += __shfl_xor(v, o);
    return v;
}
__device__ __forceinline__ float sigmoidf_(float x) { return __builtin_amdgcn_rcpf(1.0f + __expf(-x)); }
__device__ __forceinline__ float gelu_tanh(float x) { const float u = 1.5957691216057308f * (x + 0.044715f * x * x * x); return x * __builtin_amdgcn_rcpf(1.0f + __expf(-u)); }
#define OPAQUE_GPTR(p) do { GAS unsigned char* _g = (GAS unsigned char*)(p); asm volatile("" : "+s"(_g)); (p) = (decltype(p))_g; } while (0)
#define VM_WAIT() asm volatile("s_waitcnt vmcnt(0)" ::: "memory")
#define LDS_WAIT() asm volatile("s_waitcnt lgkmcnt(0)" ::: "memory")

#define XB_TMO      128
#define XB_XCNT(j)  (256  + 64 * (j))
#define XB_XSUB(j)  (1280 + 64 * (j))
#define XB_XGEN(j)  (2304 + 64 * (j))
#define XB_TOP      3328
#define XB_TOPGEN   3392
#define XCD_BAR_WORDS 3456
#define XB_SPIN_CAP (1u << 18)
__device__ __forceinline__ unsigned xb_ld(unsigned* p)              { return __hip_atomic_load(p, __ATOMIC_RELAXED, __HIP_MEMORY_SCOPE_AGENT); }
__device__ __forceinline__ unsigned xb_add(unsigned* p, unsigned v) { return __hip_atomic_fetch_add(p, v, __ATOMIC_RELAXED, __HIP_MEMORY_SCOPE_AGENT); }
__device__ __forceinline__ unsigned xb_xcc_id() { return (unsigned)__builtin_amdgcn_s_getreg((3 << 11) | 20) & 0xFu; }
#define XB_SPIN(cond, bar) do { unsigned _sp = 0; while (cond) { __builtin_amdgcn_s_sleep(1); \
    if ((++_sp & 255u) == 0u) { if (xb_ld(&(bar)[XB_TMO])) break; if (_sp > XB_SPIN_CAP) { atomicAdd(&(bar)[XB_TMO], 1u); break; } } } } while (0)
struct XcdBarrier { unsigned* bar; unsigned x; volatile LAS unsigned* st; };
__device__ __forceinline__ XcdBarrier xcd_barrier_post(unsigned* bar, volatile LAS unsigned* st) {
    XcdBarrier b; b.bar = bar; b.x = xb_xcc_id(); b.st = st;
    if (threadIdx.x == 0) (void)xb_add(&bar[XB_XCNT(b.x)], 1u);
    return b;
}
__device__ __forceinline__ void xcd_barrier_complete(unsigned* bar, unsigned x, unsigned& nloc, unsigned& nx) {
    const unsigned G = gridDim.x * gridDim.y * gridDim.z;
    unsigned sum, cnt, mine, sp = 0u;
    for (;;) {
        sum = 0u; cnt = 0u; mine = 0u;
#pragma unroll
        for (unsigned j = 0; j < 16; ++j) { const unsigned c = xb_ld(&bar[XB_XCNT(j)]); sum += c; cnt += (c > 0u) ? 1u : 0u; mine = (j == x) ? c : mine; }
        if (sum == G) break;
        __builtin_amdgcn_s_sleep(1);
        if ((++sp & 255u) == 0u) { if (xb_ld(&bar[XB_TMO])) break; if (sp > XB_SPIN_CAP) { atomicAdd(&bar[XB_TMO], 1u); break; } }
    }
    nloc = mine > 0u ? mine : 1u; nx = cnt > 0u ? cnt : 1u;
}
__device__ __forceinline__ void xcd_barrier(const XcdBarrier& b) {
    asm volatile("s_waitcnt vmcnt(0)" ::: "memory");
    __syncthreads();
    if (threadIdx.x == 0) {
        unsigned* bar = b.bar;
        __builtin_amdgcn_s_waitcnt(0);
        unsigned nloc = b.st[0], nx = b.st[1];
        if (nloc == 0u) { xcd_barrier_complete(bar, b.x, nloc, nx); b.st[0] = nloc; b.st[1] = nx; }
        const unsigned old = xb_add(&bar[XB_XSUB(b.x)], 1u);
        const unsigned gen = old / nloc;
        if (old + 1u == (gen + 1u) * nloc) {
            __builtin_amdgcn_fence(__ATOMIC_RELEASE, "agent");
            asm volatile("s_waitcnt vmcnt(0)" ::: "memory");
            const unsigned og = xb_add(&bar[XB_TOP], 1u);
            const unsigned tg = og / nx;
            if (og + 1u == (tg + 1u) * nx) xb_add(&bar[XB_TOPGEN], 1u);
            else XB_SPIN(xb_ld(&bar[XB_TOPGEN]) == tg, bar);
            __builtin_amdgcn_fence(__ATOMIC_ACQUIRE, "agent");
            xb_add(&bar[XB_XGEN(b.x)], 1u);
            asm volatile("s_waitcnt vmcnt(0)" ::: "memory");
        } else {
            XB_SPIN(xb_ld(&bar[XB_XGEN(b.x)]) == gen, bar);
            __builtin_amdgcn_fence(__ATOMIC_ACQUIRE, "agent");
            asm volatile("s_waitcnt vmcnt(0)" ::: "memory");
        }
    }
    __syncthreads();
}

namespace pg8 {
constexpr int BM = 256, BK = 64, HALF = 128, HTB = HALF * BK * 2, STAGE_BYTES = 8 * HTB, NXCD = 8, WGM = 8;
__host__ __device__ __forceinline__ int lds_byte(int r, int c) { const int st = (r >> 4) * 2 + (c >> 5), rr = r & 15, cc = c & 31, ob = rr * 64 + cc * 2; return st * 1024 + (ob ^ (((ob >> 9) & 1) << 5)); }
__host__ __device__ __forceinline__ void stage_rc(int b, int& R, int& C) { const int st = b / 1024, sb = b % 1024, swz = sb ^ (((sb >> 9) & 1) << 5); R = (st >> 1) * 16 + swz / 64; C = (st & 1) * 32 + (swz % 64) / 2; }
__host__ __device__ __forceinline__ int perm32(int rho) { const int n = rho >> 4, i = rho & 15; return 8 * (i >> 2) + 4 * n + (i & 3); }

struct Unit { int pm, pn, sub, g; size_t aoff, boff; };
struct Gemm { const bf16_t* A; const bf16_t* Bt; int lda, ldb, K; };

struct SchedGrid {
    int nM, nN, nwg, G, c, nMh; size_t astep, bstep, ahalf;
    __device__ void init(int nM_, int nN_, int G_, int c_, size_t astep_, size_t bstep_) { nM = nM_; nN = nN_; nwg = nM * nN; G = G_; c = c_; astep = astep_; bstep = bstep_; nMh = 0; ahalf = 0; }
    __device__ __forceinline__ bool next(int i, Unit& u) const {
        const long L = (long)i * G + c; if (L >= nwg) return false;
        int wgid = (int)L; { const int q = nwg / NXCD, r = nwg % NXCD, xcd = wgid % NXCD, off = wgid / NXCD; wgid = (xcd < r ? xcd * (q + 1) : r * (q + 1) + (xcd - r) * q) + off; }
        const int nig = WGM * nN, gid = wgid / nig, fm = gid * WGM, gsz = (nM - fm) < WGM ? (nM - fm) : WGM;
        u.pm = fm + ((wgid % nig) % gsz); u.pn = (wgid % nig) / gsz; u.sub = 0; u.g = 0;
        u.aoff = nMh ? (size_t)(u.pm % nMh) * astep + (size_t)(u.pm / nMh) * ahalf : (size_t)u.pm * astep; u.boff = (size_t)u.pn * bstep; return true;
    }
};
struct SchedProj {
    int G, c; size_t alo, blo;
    __device__ bool next(int i, Unit& u) const {
        const int ni = c < 128 ? (128 - c + G - 1) / G : 0;
        if (i < 3 * ni) { const int k = i / 3, sub = i - 3 * k, t = c + k * G; u.pm = t >> 1; u.pn = 6 + (t & 1); u.sub = sub; u.g = 0;
            u.aoff = (size_t)u.pm * 256 * D * 2 + (sub == 1 ? alo : (size_t)0); u.boff = sub == 2 ? blo + (size_t)(t & 1) * 256 * D * 2 : (size_t)u.pn * 256 * D * 2; return true; }
        const int j = i - 3 * ni; int r;
        if (G == 256) { if (c < 128) { if (j >= 5) return false; r = c * 5 + j; } else { if (j >= 8) return false; r = 640 + (c - 128) * 8 + j; } }
        else { r = c + j * G; if (r >= 1664) return false; }
        const int pm = r / 26, k = r - pm * 26; u.pm = pm; u.pn = k < 6 ? k : k + 2; u.sub = 0; u.g = 0; u.aoff = (size_t)pm * 256 * D * 2; u.boff = (size_t)u.pn * 256 * D * 2; return true;
    }
};
struct SchedMerge {
    SchedGrid S; size_t abr, bbr;
    __device__ bool next(int i, Unit& u) const {
        const int round = i / 3, sub = i - round * 3;
        if (!S.next(round, u)) return false;
        u.sub = sub; u.aoff += (size_t)sub * abr; u.boff += (size_t)sub * bbr; return true;
    }
};
struct SchedS5 {
    int G, c, npn;
    __device__ bool next(int i, Unit& u) const {
        const int L = i * G + c; const int per_g = 2 * npn; if (L >= 32 * per_g) return false;
        const int g = L / per_g, r = L - g * per_g; u.g = g; u.pm = r / npn; u.pn = r - u.pm * npn; u.sub = 0;
        u.aoff = ((size_t)g * 512 + (size_t)u.pm * 256) * S5K * 2;
        u.boff = npn == 1 ? (size_t)g * 256 * 512 * 2 : ((size_t)g * 512 + (size_t)u.pn * 256) * S5K * 2;
        return true;
    }
};

#ifndef PG8_SP2
#define PG8_SP2 true
#endif
#ifndef PG8_ALIGN
#define PG8_ALIGN true
#endif
template <class Epi, class Sched, bool ALIGN_EPI = PG8_ALIGN, bool SP2 = PG8_SP2>
__device__ __forceinline__ void gemm_phase(LAS unsigned char* lds, const Gemm g, const Sched& S, const Epi& E) {
    int tid = threadIdx.x; asm volatile("" : "+v"(tid));
    const int wid = __builtin_amdgcn_readfirstlane(tid >> 6), lane = tid & 63, wr = wid >> 2, wc = wid & 3, fr = lane & 15, fq = lane >> 4;
    const int K = g.K, nt = K / BK;
    const char* gA = (const char*)g.A; const char* gB = (const char*)g.Bt;
    OPAQUE_GPTR(gA); OPAQUE_GPTR(gB);
    unsigned voffA[2], voffB[2];
#pragma unroll
    for (int i = 0; i < 2; ++i) { int R, C; stage_rc(tid * 16 + i * 8192, R, C); const int Rb = (R & ~31) + perm32(R & 31);
        voffA[i] = (unsigned)(R * g.lda + C) * 2u; voffB[i] = (unsigned)(Rb * g.ldb + C) * 2u; }
    const size_t kstep = (size_t)(BK * 2);
    const size_t hstepA = (size_t)HALF * g.lda * 2, hstepB = (size_t)HALF * g.ldb * 2;
    const unsigned ldsw = (unsigned)wid * 1024u;
    const int aoff = lds_byte(wr * 64 + fr, fq * 8), boff = lds_byte(wc * 32 + fr, fq * 8);
#define PG8_SA(b, h) (((b) * 2 + (h)) * HTB)
#define PG8_SB(b, h) ((4 + (b) * 2 + (h)) * HTB)
#define PG8_STAGE(bufoff, gbase, voff) do { _Pragma("unroll") for (int _i = 0; _i < 2; ++_i) \
        __builtin_amdgcn_global_load_lds((const unsigned*)((const char*)(gbase) + (voff)[_i]), (LAS unsigned*)(lds + (bufoff) + ldsw + _i * 8192), 16, 0, 0); } while (0)
#define PG8_LDA(dst, b, h) do { _Pragma("unroll") for (int m = 0; m < 4; ++m) _Pragma("unroll") for (int k = 0; k < 2; ++k) dst[m][k] = *(const LAS bf16x8*)(lds + PG8_SA(b, h) + aoff + m * 2048 + k * 1024); } while (0)
#define PG8_LDB(dst, b, h) do { _Pragma("unroll") for (int n = 0; n < 2; ++n) _Pragma("unroll") for (int k = 0; k < 2; ++k) dst[n][k] = *(const LAS bf16x8*)(lds + PG8_SB(b, h) + boff + n * 2048 + k * 1024); } while (0)
#define PG8_MMA(ai, bj, At, Bt) do { __builtin_amdgcn_s_setprio(1); _Pragma("unroll") for (int m = 0; m < 4; ++m) _Pragma("unroll") for (int n = 0; n < 2; ++n) _Pragma("unroll") for (int k = 0; k < 2; ++k) \
        acc[ai][bj][m][n] = __builtin_amdgcn_mfma_f32_16x16x32_f16(__builtin_bit_cast(f16x8, Bt[n][k]), __builtin_bit_cast(f16x8, At[m][k]), acc[ai][bj][m][n], 0, 0, 0); __builtin_amdgcn_s_setprio(0); } while (0)
#define PG8_WAIT_V(n) asm volatile("s_waitcnt vmcnt(" #n ")" ::: "memory")
#define PG8_WAIT_L(n) asm volatile("s_waitcnt lgkmcnt(" #n ")" ::: "memory")
#define PG8_BAR __builtin_amdgcn_s_barrier()
#define PG8_SCHED __builtin_amdgcn_sched_barrier(0)
    Unit cur, nxt; int ui = 0;
    if (!S.next(0, cur)) return;
    f32x4 acc[2][2][4][2];
#pragma unroll
    for (int a = 0; a < 2; ++a)
#pragma unroll
        for (int b = 0; b < 2; ++b)
#pragma unroll
            for (int m = 0; m < 4; ++m)
#pragma unroll
                for (int n = 0; n < 2; ++n) acc[a][b][m][n] = (f32x4){0.f, 0.f, 0.f, 0.f};
    bf16x8 At[4][2], B0[2][2], B1[2][2];
    const char* cA = gA + cur.aoff; const char* cB = gB + cur.boff;
    if constexpr (SP2) {
        PG8_STAGE(PG8_SB(0, 0), cB, voffB); PG8_STAGE(PG8_SB(0, 1), cB + hstepB, voffB); PG8_STAGE(PG8_SA(0, 0), cA, voffA); PG8_STAGE(PG8_SA(0, 1), cA + hstepA, voffA);
        if (wr == 1) PG8_BAR;
        PG8_WAIT_V(2); PG8_BAR;
        PG8_STAGE(PG8_SB(1, 0), cB + kstep, voffB); PG8_STAGE(PG8_SA(1, 0), cA + kstep, voffA); PG8_STAGE(PG8_SB(1, 1), cB + hstepB + kstep, voffB);
        PG8_WAIT_V(6); PG8_BAR;
    } else {
        PG8_STAGE(PG8_SB(0, 0), cB, voffB); PG8_STAGE(PG8_SA(0, 0), cA, voffA); PG8_STAGE(PG8_SB(0, 1), cB + hstepB, voffB); PG8_STAGE(PG8_SA(0, 1), cA + hstepA, voffA);
        if (wr == 1) PG8_BAR;
        PG8_WAIT_V(4); PG8_BAR;
        PG8_STAGE(PG8_SB(1, 0), cB + kstep, voffB); PG8_STAGE(PG8_SA(1, 0), cA + kstep, voffA); PG8_STAGE(PG8_SB(1, 1), cB + hstepB + kstep, voffB);
        PG8_WAIT_V(6); PG8_BAR;
    }
    for (;;) {
        const bool has_next = S.next(ui + 1, nxt);
        const char* nA = has_next ? gA + nxt.aoff : cA; const char* nB = has_next ? gB + nxt.boff : cB;
        for (int t = 0; t < nt; t += 2) {
            const bool last = (t == nt - 2);
            const char* a1 = cA + (size_t)(t + 1) * kstep;
            const char* a2 = last ? nA : cA + (size_t)(t + 2) * kstep; const char* b2 = last ? nB : cB + (size_t)(t + 2) * kstep;
            const char* a3 = a2 + kstep; const char* b3 = b2 + kstep;
            if constexpr (SP2) {
            PG8_LDB(B0, 0, 0); PG8_LDB(B1, 0, 1); PG8_SCHED; PG8_LDA(At, 0, 0); PG8_STAGE(PG8_SA(1, 1), a1 + hstepA, voffA);
            PG8_WAIT_V(8); PG8_WAIT_L(0); PG8_BAR; PG8_MMA(0, 0, At, B0); PG8_MMA(0, 1, At, B1); PG8_BAR; PG8_SCHED;
            PG8_LDA(At, 0, 1); PG8_STAGE(PG8_SB(0, 0), b2, voffB); PG8_STAGE(PG8_SB(0, 1), b2 + hstepB, voffB); PG8_STAGE(PG8_SA(0, 0), a2, voffA);
            PG8_WAIT_V(8); PG8_WAIT_L(0); PG8_BAR; PG8_MMA(1, 0, At, B0); PG8_MMA(1, 1, At, B1); PG8_BAR; PG8_SCHED;
            PG8_LDB(B0, 1, 0); PG8_LDB(B1, 1, 1); PG8_SCHED; PG8_LDA(At, 1, 0); PG8_STAGE(PG8_SA(0, 1), a2 + hstepA, voffA);
            PG8_WAIT_V(8); PG8_WAIT_L(0); PG8_BAR; PG8_MMA(0, 0, At, B0); PG8_MMA(0, 1, At, B1); PG8_BAR; PG8_SCHED;
            PG8_LDA(At, 1, 1); PG8_STAGE(PG8_SB(1, 0), b3, voffB); PG8_STAGE(PG8_SB(1, 1), b3 + hstepB, voffB); PG8_STAGE(PG8_SA(1, 0), a3, voffA);
            PG8_WAIT_V(8); PG8_WAIT_L(0); PG8_BAR; PG8_MMA(1, 0, At, B0); PG8_MMA(1, 1, At, B1); PG8_BAR; PG8_SCHED;
            } else {
            PG8_LDB(B0, 0, 0); PG8_SCHED; PG8_LDA(At, 0, 0); PG8_STAGE(PG8_SA(1, 1), a1 + hstepA, voffA);
            PG8_WAIT_L(8); PG8_BAR; PG8_WAIT_L(0); PG8_MMA(0, 0, At, B0); PG8_BAR; PG8_SCHED;
            PG8_LDB(B1, 0, 1); PG8_STAGE(PG8_SB(0, 0), b2, voffB);
            PG8_BAR; PG8_WAIT_L(0); PG8_MMA(0, 1, At, B1); PG8_BAR;
            PG8_LDA(At, 0, 1); PG8_STAGE(PG8_SA(0, 0), a2, voffA);
            PG8_BAR; PG8_WAIT_L(0); PG8_MMA(1, 0, At, B0); PG8_BAR; PG8_SCHED;
            PG8_STAGE(PG8_SB(0, 1), b2 + hstepB, voffB);
            PG8_WAIT_V(6); PG8_BAR; PG8_MMA(1, 1, At, B1); PG8_BAR;
            PG8_LDB(B0, 1, 0); PG8_SCHED; PG8_LDA(At, 1, 0); PG8_STAGE(PG8_SA(0, 1), a2 + hstepA, voffA);
            PG8_WAIT_L(8); PG8_BAR; PG8_WAIT_L(0); PG8_MMA(0, 0, At, B0); PG8_BAR; PG8_SCHED;
            PG8_LDB(B1, 1, 1); PG8_STAGE(PG8_SB(1, 0), b3, voffB);
            PG8_BAR; PG8_WAIT_L(0); PG8_MMA(0, 1, At, B1); PG8_BAR;
            PG8_LDA(At, 1, 1); PG8_STAGE(PG8_SA(1, 0), a3, voffA);
            PG8_BAR; PG8_WAIT_L(0); PG8_MMA(1, 0, At, B0); PG8_BAR; PG8_SCHED;
            PG8_STAGE(PG8_SB(1, 1), b3 + hstepB, voffB);
            PG8_WAIT_V(6); PG8_BAR; PG8_MMA(1, 1, At, B1); PG8_BAR;
            }
        }
        if constexpr (ALIGN_EPI) { if (wr == 0) PG8_BAR; }
        const bool keep = E(acc, cur, wr, wc, fr, fq);
        if (!has_next) break;
        if (!keep) {
#pragma unroll
            for (int a = 0; a < 2; ++a)
#pragma unroll
                for (int b = 0; b < 2; ++b)
#pragma unroll
                    for (int m = 0; m < 4; ++m)
#pragma unroll
                        for (int n = 0; n < 2; ++n) acc[a][b][m][n] = (f32x4){0.f, 0.f, 0.f, 0.f};
        }
        cur = nxt; cA = nA; cB = nB; ++ui;
        if constexpr (ALIGN_EPI) { if (wr == 1) PG8_BAR; }
    }
    PG8_WAIT_V(0);
    if constexpr (!ALIGN_EPI) { if (wr == 0) PG8_BAR; }
    PG8_BAR;
#undef PG8_SA
#undef PG8_SB
#undef PG8_STAGE
#undef PG8_LDA
#undef PG8_LDB
#undef PG8_MMA
#undef PG8_WAIT_V
#undef PG8_WAIT_L
#undef PG8_BAR
#undef PG8_SCHED
}
}

using pg8::Unit;
typedef f32x4 AccT[2][2][4][2];
__host__ __device__ __forceinline__ size_t avt_index(size_t b, size_t hd, size_t t) { const size_t i = t & 31; return ((b * 8 + (hd >> 6)) * 128 + (t >> 5)) * 2048 + (hd & 63) * 32 + ((i & 0x13) | ((i & 4) << 1) | ((i & 8) >> 1)); }
__device__ __forceinline__ u32x4 pack8(const f32x4 a, const f32x4 b) { u32x4 w; w.x = pk2(a[0], a[1]); w.y = pk2(a[2], a[3]); w.z = pk2(b[0], b[1]); w.w = pk2(b[2], b[3]); return w; }

#ifndef ST_WT
#define ST_WT 1
#endif
__device__ __forceinline__ void st16(void* p, const u32x4 v) {
#if ST_WT
    asm volatile("global_store_dwordx4 %0, %1, off sc1\n\ts_nop 1" :: "v"(p), "v"(v) : "memory");
#else
    *(u32x4*)p = v;
#endif
}
__device__ __forceinline__ void store_tile_bf16(const AccT& acc, bf16_t* base, size_t ld, int wr, int wc, int fr, int fq) {
#pragma unroll
    for (int ai = 0; ai < 2; ++ai)
#pragma unroll
        for (int m = 0; m < 4; ++m) { bf16_t* rowp = base + (size_t)(ai * 128 + wr * 64 + m * 16 + fr) * ld + wc * 32 + fq * 8;
#pragma unroll
            for (int bj = 0; bj < 2; ++bj) st16(rowp + bj * 128, pack8(acc[ai][bj][m][0], acc[ai][bj][m][1])); }
}
struct EpiPlain {
    bf16_t* O; int ld;
    __device__ __forceinline__ bool operator()(AccT& acc, const Unit& u, int wr, int wc, int fr, int fq) const {
        asm volatile("" : "+v"(fr), "+v"(fq));
        bf16_t* Op = O; OPAQUE_GPTR(Op); store_tile_bf16(acc, Op + (size_t)u.pm * 256 * ld + (size_t)u.pn * 256, (size_t)ld, wr, wc, fr, fq); return false; }
};
__device__ __forceinline__ unsigned dpp_prev(unsigned cur, unsigned prev, int which  ) {
    if (which == 1) { const int o = __builtin_amdgcn_update_dpp(0, (int)prev, 0x121, 0xF, 0xF, true); return (unsigned)__builtin_amdgcn_update_dpp(o, (int)cur, 0x111, 0xF, 0xF, false); }
    const int o = __builtin_amdgcn_update_dpp(0, (int)prev, 0x122, 0xF, 0xF, true); return (unsigned)__builtin_amdgcn_update_dpp(o, (int)cur, 0x112, 0xF, 0xF, false);
}
struct EpiUpConv {
    const float* cw; const float* cb; bf16_t* ACT; bf16_t* EDGE; LAS unsigned* ex;
    __device__ __forceinline__ bool operator()(AccT& acc, const Unit& u, int wr, int wc, int fr, int fq) const {
        asm volatile("" : "+v"(fr), "+v"(fq));
        const int lc0 = wc * 32 + fq * 8;
        unsigned P[2][2][4][2][2];
#pragma unroll
        for (int ai = 0; ai < 2; ++ai)
#pragma unroll
            for (int bj = 0; bj < 2; ++bj)
#pragma unroll
                for (int m = 0; m < 4; ++m)
#pragma unroll
                    for (int n = 0; n < 2; ++n) { P[ai][bj][m][n][0] = pk2(acc[ai][bj][m][n][0], acc[ai][bj][m][n][1]); P[ai][bj][m][n][1] = pk2(acc[ai][bj][m][n][2], acc[ai][bj][m][n][3]); }
        if (fr >= 14) {
#pragma unroll
            for (int ai = 0; ai < 2; ++ai)
#pragma unroll
                for (int bj = 0; bj < 2; ++bj) { u32x4 w; w.x = P[ai][bj][3][0][0]; w.y = P[ai][bj][3][0][1]; w.z = P[ai][bj][3][1][0]; w.w = P[ai][bj][3][1][1];
                    *(LAS u32x4*)(ex + (((ai * 2 + wr) * 2 + (fr - 14)) * 2 + bj) * 64 + (lc0 >> 1)) = w; }
        }
        bf16_t* edge = EDGE + ((size_t)u.pm * 22 + u.pn) * 1024;
        if (wr == 0 && fr < 2) {
#pragma unroll
            for (int bj = 0; bj < 2; ++bj) { u32x4 w; w.x = P[0][bj][0][0][0]; w.y = P[0][bj][0][0][1]; w.z = P[0][bj][0][1][0]; w.w = P[0][bj][0][1][1]; *(u32x4*)(edge + fr * 256 + bj * 128 + lc0) = w; } }
        if (wr == 1 && fr >= 14) {
#pragma unroll
            for (int bj = 0; bj < 2; ++bj) { u32x4 w; w.x = P[1][bj][3][0][0]; w.y = P[1][bj][3][0][1]; w.z = P[1][bj][3][1][0]; w.w = P[1][bj][3][1][1]; *(u32x4*)(edge + 512 + (fr - 14) * 256 + bj * 128 + lc0) = w; } }
        __builtin_amdgcn_s_barrier();
        const float* cwp = cw; const float* cbp = cb; OPAQUE_GPTR(cwp); OPAQUE_GPTR(cbp);
        const int gcol0 = u.pn * 128 + lc0;
        f16x2 wg[2][3][2], wv[2][3][2], bgp[2][2], bvp[2][2];
#pragma unroll
        for (int n = 0; n < 2; ++n) { const int gc = gcol0 + 4 * n;
            const f32x4 g0 = *(const f32x4*)(cwp + gc), g1 = *(const f32x4*)(cwp + DUP + gc), g2 = *(const f32x4*)(cwp + 2 * DUP + gc), gb = *(const f32x4*)(cbp + gc);
            const f32x4 v0 = *(const f32x4*)(cwp + DFF + gc), v1 = *(const f32x4*)(cwp + DUP + DFF + gc), v2 = *(const f32x4*)(cwp + 2 * DUP + DFF + gc), vb = *(const f32x4*)(cbp + DFF + gc);
#pragma unroll
            for (int pr = 0; pr < 2; ++pr) { wg[n][0][pr] = __builtin_bit_cast(f16x2, pk2(g0[2 * pr], g0[2 * pr + 1])); wg[n][1][pr] = __builtin_bit_cast(f16x2, pk2(g1[2 * pr], g1[2 * pr + 1])); wg[n][2][pr] = __builtin_bit_cast(f16x2, pk2(g2[2 * pr], g2[2 * pr + 1]));
                bgp[n][pr] = __builtin_bit_cast(f16x2, pk2(gb[2 * pr], gb[2 * pr + 1])); wv[n][0][pr] = __builtin_bit_cast(f16x2, pk2(v0[2 * pr], v0[2 * pr + 1])); wv[n][1][pr] = __builtin_bit_cast(f16x2, pk2(v1[2 * pr], v1[2 * pr + 1]));
                wv[n][2][pr] = __builtin_bit_cast(f16x2, pk2(v2[2 * pr], v2[2 * pr + 1])); bvp[n][pr] = __builtin_bit_cast(f16x2, pk2(vb[2 * pr], vb[2 * pr + 1])); } }
#pragma unroll
        for (int ai = 0; ai < 2; ++ai) {
            const int blk = ai * 2 + wr;
            unsigned pg[2][2] = {{0u, 0u}, {0u, 0u}}, pv[2][2] = {{0u, 0u}, {0u, 0u}};
            if (blk > 0) { const u32x4 a = *(const LAS u32x4*)(ex + ((((blk - 1) * 2 + (fr & 1)) * 2 + 0) * 64) + (lc0 >> 1)), b = *(const LAS u32x4*)(ex + ((((blk - 1) * 2 + (fr & 1)) * 2 + 1) * 64) + (lc0 >> 1));
                pg[0][0] = a.x; pg[0][1] = a.y; pg[1][0] = a.z; pg[1][1] = a.w; pv[0][0] = b.x; pv[0][1] = b.y; pv[1][0] = b.z; pv[1][1] = b.w; }
#pragma unroll
            for (int m = 0; m < 4; ++m) { float o[8];
#pragma unroll
                for (int n = 0; n < 2; ++n)
#pragma unroll
                    for (int pr = 0; pr < 2; ++pr) { const unsigned cg = P[ai][0][m][n][pr], cv = P[ai][1][m][n][pr];
                        const unsigned xg1 = dpp_prev(cg, pg[n][pr], 1), xg2 = dpp_prev(cg, pg[n][pr], 2), xv1 = dpp_prev(cv, pv[n][pr], 1), xv2 = dpp_prev(cv, pv[n][pr], 2);
                        const int j = 4 * n + 2 * pr;
                        const f16x2 gq = wg[n][2][pr] * __builtin_bit_cast(f16x2, cg) + wg[n][1][pr] * __builtin_bit_cast(f16x2, xg1) + wg[n][0][pr] * __builtin_bit_cast(f16x2, xg2) + bgp[n][pr];
                        const f16x2 vq = wv[n][2][pr] * __builtin_bit_cast(f16x2, cv) + wv[n][1][pr] * __builtin_bit_cast(f16x2, xv1) + wv[n][0][pr] * __builtin_bit_cast(f16x2, xv2) + bvp[n][pr];
                        o[j] = gelu_tanh((float)gq[0]) * (float)vq[0]; o[j + 1] = gelu_tanh((float)gq[1]) * (float)vq[1]; pg[n][pr] = cg; pv[n][pr] = cv; }
                { u32x4 w; w.x = pk2(o[0], o[1]); w.y = pk2(o[2], o[3]); w.z = pk2(o[4], o[5]); w.w = pk2(o[6], o[7]); st16(ACT + ((size_t)u.pm * 256 + ai * 128 + wr * 64 + m * 16 + fr) * DFF + gcol0, w); }
                __builtin_amdgcn_sched_barrier(0);
            }
        }
        __builtin_amdgcn_s_barrier();
        return false;
    }
};
struct EpiProj {
    unsigned char* reg_;
    __device__ __forceinline__ bool operator()(AccT& acc, const Unit& u, int wr, int wc, int fr, int fq) const {
        asm volatile("" : "+v"(fr), "+v"(fq));
        unsigned char* reg = reg_; OPAQUE_GPTR(reg);
        const int pn = u.pn; const size_t r0 = (size_t)u.pm * 256;
        if (pn < 4) { bf16_t* O = (bf16_t*)(reg + (pn < 2 ? R_AQ : R_AK)); store_tile_bf16(acc, O + r0 * 512 + (size_t)(pn & 1) * 256, 512, wr, wc, fr, fq); }
        else if (pn < 6) {
            bf16_t* O = (bf16_t*)(reg + R_AVT);
#pragma unroll
            for (int ai = 0; ai < 2; ++ai)
#pragma unroll
                for (int m = 0; m < 4; ++m) { const size_t r = r0 + ai * 128 + wr * 64 + m * 16 + fr; const size_t b = r >> 12, t = r & 4095;
#pragma unroll
                    for (int bj = 0; bj < 2; ++bj) { const int hd0 = (pn - 4) * 256 + bj * 128 + wc * 32 + fq * 8;
#pragma unroll
                        for (int n = 0; n < 2; ++n)
#pragma unroll
                            for (int j = 0; j < 4; ++j) O[avt_index(b, hd0 + n * 4 + j, t)] = f2h(acc[ai][bj][m][n][j]); } }
        }
        else if (pn == 6) {
            if (IDX_SPLIT && u.sub < 2) return true;
#pragma unroll
            for (int ai = 0; ai < 2; ++ai)
#pragma unroll
                for (int m = 0; m < 4; ++m) { const size_t off = (r0 + ai * 128 + wr * 64 + m * 16 + fr) * 256 + wc * 32 + fq * 8;
#pragma unroll
                    for (int bj = 0; bj < 2; ++bj) { const f32x4 a = acc[ai][bj][m][0], b = acc[ai][bj][m][1]; const u32x4 hi = pack8(a, b);
                        const f32x4 al = {a[0] - hlo(hi.x), a[1] - hhi(hi.x), a[2] - hlo(hi.y), a[3] - hhi(hi.y)}, bl = {b[0] - hlo(hi.z), b[1] - hhi(hi.z), b[2] - hlo(hi.w), b[3] - hhi(hi.w)};
                        *(u32x4*)((bf16_t*)(reg + R_IQH) + off + bj * 128) = hi; if (IDX_SPLIT) *(u32x4*)((bf16_t*)(reg + R_IQL) + off + bj * 128) = pack8(al, bl); } }
        }
        else if (pn == 7) {
            if (IDX_SPLIT && u.sub < 2) return true;
            if (wc < 2) {
#pragma unroll
                for (int ai = 0; ai < 2; ++ai)
#pragma unroll
                    for (int m = 0; m < 4; ++m) { const size_t r = r0 + ai * 128 + wr * 64 + m * 16 + fr; const f32x4 a = acc[ai][0][m][0], b = acc[ai][0][m][1];
                        if (wc == 0) { const u32x4 hi = pack8(a, b);
                            const f32x4 al = {a[0] - hlo(hi.x), a[1] - hhi(hi.x), a[2] - hlo(hi.y), a[3] - hhi(hi.y)}, bl = {b[0] - hlo(hi.z), b[1] - hhi(hi.z), b[2] - hlo(hi.w), b[3] - hhi(hi.w)};
                            *(u32x4*)((bf16_t*)(reg + R_IKH) + r * 32 + fq * 8) = hi; if (IDX_SPLIT) *(u32x4*)((bf16_t*)(reg + R_IKL) + r * 32 + fq * 8) = pack8(al, bl); }
                        else if (fq == 0) { float* o = (float*)(reg + R_IW) + r * 8; *(f32x4*)o = a * 0.0625f; *(f32x4*)(o + 4) = b * 0.0625f; }
                        else if (fq < 3) { float* o = (float*)(reg + R_GLR) + r * 16 + (fq - 1) * 8; *(f32x4*)o = a; *(f32x4*)(o + 4) = b; } }
            }
        }
        else if (pn < 10) {
            bf16_t* O = (bf16_t*)(reg + R_S5A);
#pragma unroll
            for (int ai = 0; ai < 2; ++ai)
#pragma unroll
                for (int m = 0; m < 4; ++m) { const size_t r = r0 + ai * 128 + wr * 64 + m * 16 + fr; const size_t b = r >> 12, t = r & 4095, ch = t >> 5, j = t & 31;
#pragma unroll
                    for (int bj = 0; bj < 2; ++bj) { const int c = (pn - 8) * 256 + bj * 128 + wc * 32 + fq * 8; const size_t g = c >> 4, p = c & 15;
                        *(u32x4*)(O + ((g * 512 + b * 128 + ch) * S5K + j * 16 + p)) = pack8(acc[ai][bj][m][0], acc[ai][bj][m][1]); } }
        }
        else if (pn < 12) store_tile_bf16(acc, (bf16_t*)(reg + (pn == 10 ? R_GQ : R_GK)) + r0 * 256, 256, wr, wc, fr, fq);
        else if (pn < 16) { bf16_t* O = (bf16_t*)(reg + (pn < 14 ? R_GV : R_GR)); store_tile_bf16(acc, O + r0 * 512 + (size_t)(pn & 1) * 256, 512, wr, wc, fr, fq); }
        else {
            const int c0 = (pn - 16) * 256, br = c0 >> 10, d0 = c0 & 1023;
            bf16_t* O = (bf16_t*)(reg + R_GATES) + ((size_t)br * MH + r0) * D + d0;
#pragma unroll
            for (int ai = 0; ai < 2; ++ai)
#pragma unroll
                for (int m = 0; m < 4; ++m) { bf16_t* rowp = O + (size_t)(ai * 128 + wr * 64 + m * 16 + fr) * D + wc * 32 + fq * 8;
#pragma unroll
                    for (int bj = 0; bj < 2; ++bj) { f32x4 a = acc[ai][bj][m][0], b = acc[ai][bj][m][1];
#pragma unroll
                        for (int j = 0; j < 4; ++j) { a[j] = fmaxf(sigmoidf_(a[j]), 6.2e-5f); b[j] = fmaxf(sigmoidf_(b[j]), 6.2e-5f); }
#ifdef DBG_ZERO_BRANCH
                        if (br == DBG_ZERO_BRANCH) { a = (f32x4){6.2e-5f, 6.2e-5f, 6.2e-5f, 6.2e-5f}; b = a; }
#endif
                        *(u32x4*)(rowp + bj * 128) = pack8(a, b); } }
        }
        return false;
    }
};
struct EpiS5State {
    float* SC;
    __device__ __forceinline__ bool operator()(AccT& acc, const Unit& u, int wr, int wc, int fr, int fq) const {
        asm volatile("" : "+v"(fr), "+v"(fq));
#pragma unroll
        for (int ai = 0; ai < 2; ++ai)
#pragma unroll
            for (int m = 0; m < 4; ++m) { const size_t row = (size_t)u.pm * 256 + ai * 128 + wr * 64 + m * 16 + fr; float* o = SC + ((size_t)u.g * 512 + row) * 128 + wc * 32 + fq * 8;
                *(f32x4*)o = acc[ai][0][m][0]; *(f32x4*)(o + 4) = acc[ai][0][m][1]; }
        return false;
    }
};
struct EpiS5Out {
    const bf16_t* A; const float* dsk; bf16_t* GA;
    __device__ __forceinline__ bool operator()(AccT& acc, const Unit& u, int wr, int wc, int fr, int fq) const {
        asm volatile("" : "+v"(fr), "+v"(fq));
#pragma unroll
        for (int ai = 0; ai < 2; ++ai)
#pragma unroll
            for (int m = 0; m < 4; ++m) { const size_t row = (size_t)u.pm * 256 + ai * 128 + wr * 64 + m * 16 + fr; const size_t b = row >> 7, ch = row & 127;
#pragma unroll
                for (int bj = 0; bj < 2; ++bj) { const int col = u.pn * 256 + bj * 128 + wc * 32 + fq * 8; const int j = col >> 4, p = col & 15;
                    const u32x4 uu = *(const u32x4*)(A + (((size_t)u.g * 512 + row) * S5K + col));
                    const f32x4 d0 = *(const f32x4*)(dsk + u.g * 16 + p), d1 = *(const f32x4*)(dsk + u.g * 16 + p + 4);
                    f32x4 a = acc[ai][bj][m][0], c = acc[ai][bj][m][1];
                    a[0] += d0[0] * hlo(uu.x); a[1] += d0[1] * hhi(uu.x); a[2] += d0[2] * hlo(uu.y); a[3] += d0[3] * hhi(uu.y);
                    c[0] += d1[0] * hlo(uu.z); c[1] += d1[1] * hhi(uu.z); c[2] += d1[2] * hlo(uu.w); c[3] += d1[3] * hhi(uu.w);
#pragma unroll
                    for (int q = 0; q < 4; ++q) { a[q] = gelu_tanh(a[q]); c[q] = gelu_tanh(c[q]); }
                    *(u32x4*)(GA + ((b * 4096 + ch * 32 + j) * 512 + u.g * 16 + p)) = pack8(a, c); } }
        return false;
    }
};
struct EpiGlu {
    bf16_t* O;
    __device__ __forceinline__ bool operator()(AccT& acc, const Unit& u, int wr, int wc, int fr, int fq) const {
        asm volatile("" : "+v"(fr), "+v"(fq));
#pragma unroll
        for (int ai = 0; ai < 2; ++ai)
#pragma unroll
            for (int m = 0; m < 4; ++m) { const size_t row = (size_t)u.pm * 256 + ai * 128 + wr * 64 + m * 16 + fr;
                f32x4 a = acc[ai][0][m][0], c = acc[ai][0][m][1]; const f32x4 ga = acc[ai][1][m][0], gc = acc[ai][1][m][1];
#pragma unroll
                for (int q = 0; q < 4; ++q) { a[q] *= sigmoidf_(ga[q]); c[q] *= sigmoidf_(gc[q]); }
                *(u32x4*)(O + row * 512 + u.pn * 128 + wc * 32 + fq * 8) = pack8(a, c); }
        return false;
    }
};
struct EpiMerge {
    const bf16_t* GT; bf16_t* O;
    __device__ __forceinline__ bool operator()(AccT& acc, const Unit& u, int wr, int wc, int fr, int fq) const {
        asm volatile("" : "+v"(fr), "+v"(fq));
        const int sub = u.sub;
        const bf16_t* GTp = GT; OPAQUE_GPTR(GTp);
#pragma unroll
        for (int ai = 0; ai < 2; ++ai) {
            u32x4 G0[4][2], G1[4][2];
#pragma unroll
            for (int m = 0; m < 4; ++m)
#pragma unroll
                for (int bj = 0; bj < 2; ++bj) { const size_t row = (size_t)u.pm * 256 + ai * 128 + wr * 64 + m * 16 + fr, col = (size_t)u.pn * 256 + bj * 128 + wc * 32 + fq * 8;
                    G0[m][bj] = *(const u32x4*)(GTp + ((size_t)sub * MH + row) * D + col);
                    G1[m][bj] = G0[m][bj]; if (sub < 2) G1[m][bj] = *(const u32x4*)(GTp + ((size_t)(sub + 1) * MH + row) * D + col); }
#pragma unroll
            for (int m = 0; m < 4; ++m)
#pragma unroll
                for (int bj = 0; bj < 2; ++bj) asm volatile("" : "+v"(G0[m][bj]), "+v"(G1[m][bj]));
#pragma unroll
            for (int m = 0; m < 4; ++m) { const size_t row = (size_t)u.pm * 256 + ai * 128 + wr * 64 + m * 16 + fr;
#pragma unroll
                for (int bj = 0; bj < 2; ++bj) { const size_t col = (size_t)u.pn * 256 + bj * 128 + wc * 32 + fq * 8;
                    const u32x4 g0 = G0[m][bj];
                    f32x4 s0 = {hlo(g0.x), hhi(g0.x), hlo(g0.y), hhi(g0.y)}, s1 = {hlo(g0.z), hhi(g0.z), hlo(g0.w), hhi(g0.w)};
                    if (sub < 2) { const u32x4 g1 = G1[m][bj];
                        const f32x4 t0 = {hlo(g1.x), hhi(g1.x), hlo(g1.y), hhi(g1.y)}, t1 = {hlo(g1.z), hhi(g1.z), hlo(g1.w), hhi(g1.w)};
#pragma unroll
                        for (int q = 0; q < 4; ++q) { s0[q] *= __builtin_amdgcn_rcpf(t0[q]); s1[q] *= __builtin_amdgcn_rcpf(t1[q]); } }
                    acc[ai][bj][m][0] *= s0; acc[ai][bj][m][1] *= s1;
                    if (sub == 2) *(u32x4*)(O + row * D + col) = pack8(acc[ai][bj][m][0], acc[ai][bj][m][1]); } }
        }
        return sub < 2;
    }
};

struct Ctx { LAS unsigned char* lds; int tid, lane, wave, vcu, G; };
#define FRESH_CTX(X, X_) Ctx X = X_; asm volatile("" : "+v"(X.tid), "+v"(X.lane)); asm volatile("" : "+s"(X.wave), "+s"(X.vcu))

__device__ __forceinline__ void phase_adaln(const Ctx& X_, const float* c, const float* mixw, const float* mixb, const float* ffnw, const float* ffnb, float* mod) {
    FRESH_CTX(X, X_);
    LAS float* sc = (LAS float*)X.lds; LAS float* red = sc + 8192;
    for (int i = X.tid; i < 8192; i += 512) { const float v = c[i]; sc[i] = v * sigmoidf_(v); }
    __syncthreads();
    for (int unit = X.vcu; unit < 384; unit += X.G) {
        const int l = unit / 96, w = (unit / 48) & 1, cg = unit % 48, col = cg * 64 + X.lane;
        const float* W = (w ? ffnw : mixw) + (size_t)l * 1024 * 3072; const float* bias = (w ? ffnb : mixb) + l * 3072;
        float a[8];
#pragma unroll
        for (int b = 0; b < 8; ++b) a[b] = 0.f;
        for (int k = X.wave * 128; k < X.wave * 128 + 128; ++k) { const float wv = W[(size_t)k * 3072 + col];
#pragma unroll
            for (int b = 0; b < 8; ++b) a[b] = fmaf(sc[b * 1024 + k], wv, a[b]); }
#pragma unroll
        for (int b = 0; b < 8; ++b) red[(X.wave * 8 + b) * 64 + X.lane] = a[b];
        __syncthreads();
        { const int b = X.tid >> 6; float s = bias[col];
#pragma unroll
            for (int w8 = 0; w8 < 8; ++w8) s += red[(w8 * 8 + b) * 64 + X.lane];
            mod[(((size_t)l * 2 + w) * 8 + b) * 3072 + col] = s; }
        __syncthreads();
    }
}

struct MapId { __device__ __forceinline__ int operator()(int n) const { return n; } };
struct MapWin { __device__ __forceinline__ int operator()(int n) const {
    if (n < 1792) return n;
    if (n < 2048) { const int c = n - 1792; return c < 32 ? 1792 + c : (c < 40 ? 1824 + (c - 32) : (c < 56 ? 3880 + (c - 40) : -1)); }
    if (n < 2560) return 1832 + (n - 2048);
    if (n < 2816) return 2344 + (n - 2560);
    if (n < 3072) return 2600 + (n - 2816);
    if (n < 3584) return 2856 + (n - 3072);
    if (n < 4096) return 3368 + (n - 3584);
    return 3896 + (n - 4096); } };
struct MapWinLo { __device__ __forceinline__ int operator()(int n) const { return MapWin()(1536 + n); } };
struct MapUp { __device__ __forceinline__ int operator()(int n) const { const int pn = n >> 8, r = n & 255; return r < 128 ? 128 * pn + r : DFF + 128 * pn + (r - 128); } };
struct MapGlu { __device__ __forceinline__ int operator()(int n) const { const int pn = n >> 8, r = n & 255; return r < 128 ? 128 * pn + r : 512 + 128 * pn + (r - 128); } };
template <class Map, bool LO = false>
__device__ __forceinline__ void conv_item(const float* W, int K, int Nsrc, bf16_t* WT, LAS float* scr, int item, int nblk, int lane, const Map& map) {
    const int kb = item / nblk, nb = item - kb * nblk, k0 = 64 * kb, n0 = 32 * nb;
    const int n4 = 4 * (lane & 7), kr = lane >> 3; const int sc = map(n0 + n4);
    f32x4 wv[8];
    const int scl = sc >= 0 ? sc : 0;
#pragma unroll
    for (int i = 0; i < 8; ++i) wv[i] = *(const f32x4*)(W + (size_t)(k0 + 8 * i + kr) * Nsrc + scl);
#pragma unroll
    for (int i = 0; i < 8; ++i) asm volatile("" : "+v"(wv[i]));
#pragma unroll
    for (int i = 0; i < 8; ++i) { const int kk = 8 * i + kr;
#pragma unroll
        for (int e = 0; e < 4; ++e) { float x = sc >= 0 ? wv[i][e] : 0.f; if (LO) x -= (float)(_Float16)x; scr[kk * 33 + n4 + e] = x; } }
    LDS_WAIT(); asm volatile("" ::: "memory");
    const int c = lane & 7;
#pragma unroll
    for (int j = 0; j < 4; ++j) { const int n = (lane >> 3) + 8 * j; const LAS float* s = scr + (8 * c) * 33 + n;
        u32x4 o; o.x = pk2(s[0 * 33], s[1 * 33]); o.y = pk2(s[2 * 33], s[3 * 33]); o.z = pk2(s[4 * 33], s[5 * 33]); o.w = pk2(s[6 * 33], s[7 * 33]);
        *(u32x4*)(WT + (size_t)(n0 + n) * K + k0 + 8 * c) = o; }
    LDS_WAIT(); asm volatile("" ::: "memory");
}
__device__ __forceinline__ void phase_convert(const Ctx& X_, unsigned char* ws, const float* w_in, const float* w_glu, const float* w_br, const float* w_out, const float* w_up, const float* w_dn) {
    FRESH_CTX(X, X_);
    LAS float* scr = (LAS float*)(X.lds + X.wave * 8704);
    const int gw = X.vcu * 8 + X.wave, NGW = X.G * 8;
    constexpr int I1 = 16 * 224, I2 = 8 * 32, I3 = 8 * 32, I4 = 16 * 32, I5 = 16 * 176, I6 = 44 * 32, I7 = 16 * 16, NIT = I1 + I2 + 3 * I3 + I4 + I5 + I6 + I7;
    for (int it = gw; it < NIT; it += NGW) {
        int r = it;
        if (r < I1) { conv_item(w_in, 1024, D_IN, (bf16_t*)(ws + WS_WIN), scr, r, 224, X.lane, MapWin()); continue; } r -= I1;
        if (r < I2) { conv_item(w_glu, 512, 1024, (bf16_t*)(ws + WS_WGLU), scr, r, 32, X.lane, MapGlu()); continue; } r -= I2;
        if (r < 3 * I3) { const int br = r / I3; conv_item(w_br + (size_t)br * 512 * 1024, 512, 1024, (bf16_t*)(ws + WS_WBR) + (size_t)br * 1024 * 512, scr, r - br * I3, 32, X.lane, MapId()); continue; } r -= 3 * I3;
        if (r < I4) { conv_item(w_out, 1024, 1024, (bf16_t*)(ws + WS_WOUT), scr, r, 32, X.lane, MapId()); continue; } r -= I4;
        if (r < I5) { conv_item(w_up, 1024, DUP, (bf16_t*)(ws + WS_WUP), scr, r, 176, X.lane, MapUp()); continue; } r -= I5;
        if (r < I6) { conv_item(w_dn, DFF, 1024, (bf16_t*)(ws + WS_WDN), scr, r, 32, X.lane, MapId()); continue; } r -= I6;
        if (IDX_SPLIT) conv_item<MapWinLo, true>(w_in, 1024, D_IN, (bf16_t*)(ws + WS_WINLO), scr, r, 16, X.lane, MapWinLo());
    }
}

__device__ __forceinline__ void phase_s5pre(const Ctx& X_, unsigned char* ws, const float* lam_re, const float* lam_im, const float* log_dt, const float* b_re, const float* b_im, const float* c_re, const float* c_im) {
    FRESH_CTX(X, X_);
    LAS float* pw = (LAS float*)X.lds;
    LAS float* bbr = pw + 384; LAS float* bbi = bbr + 1024; LAS float* cr = bbi + 1024; LAS float* ci = cr + 1024;
    bf16_t* BO = (bf16_t*)(ws + WS_S5BO); bf16_t* BS = (bf16_t*)(ws + WS_S5BS);
    for (int item = X.vcu; item < 256; item += X.G) {
        const int g = item >> 3, tq = item & 7;
        __syncthreads();
        const float dt = expf(log_dt[g]);
        for (int e = X.tid; e < 1024; e += 512) { const int n = e >> 4; const float lr = lam_re[g * 64 + n], li = lam_im[g * 64 + n];
            const float mag = expf(lr * dt), ar = mag * cosf(li * dt), ai = mag * sinf(li * dt), den = lr * lr + li * li, nr = ar - 1.0f, ni = ai;
            const float fr_ = (nr * lr + ni * li) / den, fi_ = (ni * lr - nr * li) / den; const float br = b_re[(size_t)g * 1024 + e], bi = b_im[(size_t)g * 1024 + e];
            bbr[e] = fr_ * br - fi_ * bi; bbi[e] = fr_ * bi + fi_ * br; }
        for (int e = X.tid; e < 1024; e += 512) { cr[e] = c_re[(size_t)g * 1024 + e]; ci[e] = c_im[(size_t)g * 1024 + e]; }
        for (int ti = 0; ti < 4; ++ti) { const int tau = tq + 8 * ti;
            if (ti) __syncthreads();
            if (X.tid < 192) { const int which = X.tid >> 6, n = X.tid & 63; const float e = which == 0 ? (float)tau : (which == 1 ? (float)(tau + 1) : (float)(31 - tau));
                const float lr = lam_re[g * 64 + n], li = lam_im[g * 64 + n], mag = expf(lr * dt * e), ang = li * dt * e; pw[which * 128 + n] = mag * cosf(ang); pw[which * 128 + 64 + n] = mag * sinf(ang); }
            __syncthreads();
            if (X.tid < 256) {
                const int po = X.tid >> 4, pi = X.tid & 15; float k = 0.f;
                for (int n = 0; n < 64; ++n) { const float c_r = cr[po * 64 + n], c_i = ci[po * 64 + n], p_r = pw[n], p_i = pw[64 + n]; k += (c_r * p_r - c_i * p_i) * bbr[n * 16 + pi] - (c_r * p_i + c_i * p_r) * bbi[n * 16 + pi]; }
                const bf16_t kh = f2h(k);
                for (int j = tau; j < 32; ++j) BO[((size_t)g * 512 + j * 16 + po) * S5K + (j - tau) * 16 + pi] = kh;
                for (int j = 0; j + tau + 1 < 32; ++j) BO[((size_t)g * 512 + j * 16 + po) * S5K + (j + tau + 1) * 16 + pi] = 0;
            } else {
                const int t2 = X.tid - 256;
                { const int po = t2 >> 4, x = t2 & 15; bf16_t* orow = BO + ((size_t)g * 512 + tau * 16 + po) * S5K;
#pragma unroll
                    for (int q = 0; q < 4; ++q) { const int n = x + 16 * q; const float c_r = cr[po * 64 + n], c_i = ci[po * 64 + n], p_r = pw[128 + n], p_i = pw[192 + n];
                        orow[512 + n] = f2h(c_r * p_r - c_i * p_i); orow[576 + n] = f2h(-(c_r * p_i + c_i * p_r)); } }
                { const int row = t2; float v[16];
#pragma unroll
                    for (int q = 0; q < 16; ++q) { v[q] = 0.f; if (row < 128) { const int n = row & 63; const float p_r = pw[256 + n], p_i = pw[320 + n], b_r = bbr[n * 16 + q], b_i = bbi[n * 16 + q];
                            v[q] = row < 64 ? p_r * b_r - p_i * b_i : p_r * b_i + p_i * b_r; } }
                    u32x4 o0, o1; o0.x = pk2(v[0], v[1]); o0.y = pk2(v[2], v[3]); o0.z = pk2(v[4], v[5]); o0.w = pk2(v[6], v[7]); o1.x = pk2(v[8], v[9]); o1.y = pk2(v[10], v[11]); o1.z = pk2(v[12], v[13]); o1.w = pk2(v[14], v[15]);
                    bf16_t* dst = BS + ((size_t)g * 256 + row) * 512 + tau * 16; *(u32x4*)dst = o0; *(u32x4*)(dst + 8) = o1; }
            }
        }
    }
}

#define ROWCOL(lane, j) (8 * (lane) + 4 * ((j) & 1) + 512 * ((j) >> 1))
__device__ __forceinline__ void row_load_f32(const float* p, int lane, f32x4 (&v)[4]) {
#pragma unroll
    for (int j = 0; j < 4; ++j) v[j] = *(const f32x4*)(p + ROWCOL(lane, j));
}
__device__ __forceinline__ void row_load_bf16(const bf16_t* p, int lane, f32x4 (&v)[4]) {
#pragma unroll
    for (int jj = 0; jj < 2; ++jj) { const u32x4 w = *(const u32x4*)(p + 8 * lane + 512 * jj); v[2 * jj] = (f32x4){hlo(w.x), hhi(w.x), hlo(w.y), hhi(w.y)}; v[2 * jj + 1] = (f32x4){hlo(w.z), hhi(w.z), hlo(w.w), hhi(w.w)}; }
}
__device__ __forceinline__ float row_rstd(const f32x4 (&v)[4]) {
    float s = 0.f;
#pragma unroll
    for (int j = 0; j < 4; ++j) s += (v[j][0] * v[j][0] + v[j][1] * v[j][1]) + (v[j][2] * v[j][2] + v[j][3] * v[j][3]);
    return rsqrtf(wave_sum(s) * (1.0f / 1024.0f) + EPS);
}
__device__ __forceinline__ void row_modulate_store(const f32x4 (&v)[4], float rstd, const float* g, const float* modv  , bf16_t* o, bf16_t* olo, int lane) {
    (void)olo;
#pragma unroll
    for (int jj = 0; jj < 2; ++jj) { u32x4 w;
#pragma unroll
        for (int q = 0; q < 2; ++q) { const int j = 2 * jj + q, c = ROWCOL(lane, j); const f32x4 gg = *(const f32x4*)(g + c), sh = *(const f32x4*)(modv + c), scl = *(const f32x4*)(modv + 1024 + c);
            const f32x4 h = v[j] * rstd * gg * (scl + 1.0f) + sh; if (q == 0) { w.x = pk2(h[0], h[1]); w.y = pk2(h[2], h[3]); } else { w.z = pk2(h[0], h[1]); w.w = pk2(h[2], h[3]); } }
        *(u32x4*)(o + 8 * lane + 512 * jj) = w; }
}
__device__ __forceinline__ void row_rstd2(const f32x4 (&a)[4], const f32x4 (&b)[4], float& ra, float& rb) {
    float sa = 0.f, sb = 0.f;
#pragma unroll
    for (int j = 0; j < 4; ++j) { sa += (a[j][0] * a[j][0] + a[j][1] * a[j][1]) + (a[j][2] * a[j][2] + a[j][3] * a[j][3]); sb += (b[j][0] * b[j][0] + b[j][1] * b[j][1]) + (b[j][2] * b[j][2] + b[j][3] * b[j][3]); }
#pragma unroll
    for (int o = 1; o < 64; o <<= 1) { sa += __shfl_xor(sa, o); sb += __shfl_xor(sb, o); }
    ra = rsqrtf(sa * (1.0f / 1024.0f) + EPS); rb = rsqrtf(sb * (1.0f / 1024.0f) + EPS);
}
__device__ __forceinline__ void phase_t1(const Ctx& X_, const float* xsrc, int hb, int l, const float* pre_g, const float* mod, bf16_t* H, bf16_t* HLO) {
    FRESH_CTX(X, X_);
    const int gw = X.vcu * 8 + X.wave, NGW = X.G * 8;
    for (int r = gw; r < MH; r += 2 * NGW) { const int r2 = r + NGW < MH ? r + NGW : r; const size_t Ra = (size_t)hb * MH + r, Rb = (size_t)hb * MH + r2;
        f32x4 va[4], vb[4]; row_load_f32(xsrc + Ra * D, X.lane, va); row_load_f32(xsrc + Rb * D, X.lane, vb); float ra, rb; row_rstd2(va, vb, ra, rb);
        row_modulate_store(va, ra, pre_g + l * D, mod + (((size_t)l * 2 + 0) * 8 + (int)(Ra >> 12)) * 3072, H + (size_t)r * D, HLO ? HLO + (size_t)r * D : nullptr, X.lane);
        row_modulate_store(vb, rb, pre_g + l * D, mod + (((size_t)l * 2 + 0) * 8 + (int)(Rb >> 12)) * 3072, H + (size_t)r2 * D, HLO ? HLO + (size_t)r2 * D : nullptr, X.lane); }
}
__device__ __forceinline__ void row_store_x16(bf16_t* p, int lane, const f32x4 (&v)[4]) {
#pragma unroll
    for (int jj = 0; jj < 2; ++jj) { u32x4 w; w.x = pk2(v[2 * jj][0], v[2 * jj][1]); w.y = pk2(v[2 * jj][2], v[2 * jj][3]); w.z = pk2(v[2 * jj + 1][0], v[2 * jj + 1][1]); w.w = pk2(v[2 * jj + 1][2], v[2 * jj + 1][3]);
        *(u32x4*)(p + 8 * lane + 512 * jj) = w; }
}
__device__ __forceinline__ void phase_t2(const Ctx& X_, const float* xin, const bf16_t* xs, bf16_t* xd, int hb, int l, const bf16_t* Y, const float* post_g, const float* fpre_g, const float* mod, bf16_t* HF) {
    FRESH_CTX(X, X_);
    const int gw = X.vcu * 8 + X.wave, NGW = X.G * 8;
    for (int r = gw; r < MH; r += 2 * NGW) { const int r2 = r + NGW < MH ? r + NGW : r; const size_t Ra = (size_t)hb * MH + r, Rb = (size_t)hb * MH + r2; const int ba = (int)(Ra >> 12), bb = (int)(Rb >> 12);
        f32x4 ya[4], yb[4], va[4], vb[4]; row_load_bf16(Y + (size_t)r * D, X.lane, ya); row_load_bf16(Y + (size_t)r2 * D, X.lane, yb);
        if (xin) { row_load_f32(xin + Ra * D, X.lane, va); row_load_f32(xin + Rb * D, X.lane, vb); } else { row_load_bf16(xs + (size_t)r * D, X.lane, va); row_load_bf16(xs + (size_t)r2 * D, X.lane, vb); }
        float rya, ryb; row_rstd2(ya, yb, rya, ryb);
        const float* mva = mod + (((size_t)l * 2 + 0) * 8 + ba) * 3072; const float* mvb = mod + (((size_t)l * 2 + 0) * 8 + bb) * 3072;
#pragma unroll
        for (int j = 0; j < 4; ++j) { const int c = ROWCOL(X.lane, j); const f32x4 gg = *(const f32x4*)(post_g + l * D + c), gta = *(const f32x4*)(mva + 2048 + c), gtb = *(const f32x4*)(mvb + 2048 + c);
            va[j] = va[j] + gta * (ya[j] * rya * gg); vb[j] = vb[j] + gtb * (yb[j] * ryb * gg); }
        row_store_x16(xd + (size_t)r * D, X.lane, va); if (r2 != r) row_store_x16(xd + (size_t)r2 * D, X.lane, vb);
        float ra, rb; row_rstd2(va, vb, ra, rb);
        row_modulate_store(va, ra, fpre_g + l * D, mod + (((size_t)l * 2 + 1) * 8 + ba) * 3072, HF + (size_t)r * D, nullptr, X.lane);
        if (r2 != r) row_modulate_store(vb, rb, fpre_g + l * D, mod + (((size_t)l * 2 + 1) * 8 + bb) * 3072, HF + (size_t)r2 * D, nullptr, X.lane); }
}
__device__ __forceinline__ void phase_t4(const Ctx& X_, const bf16_t* xs, bf16_t* xd, float* outf, bf16_t* Hn, int hb, int l, const bf16_t* Y2, const float* fpost_g, const float* pre_g, const float* mod) {
    FRESH_CTX(X, X_);
    const int gw = X.vcu * 8 + X.wave, NGW = X.G * 8;
    for (int r = gw; r < MH; r += 2 * NGW) { const int r2 = r + NGW < MH ? r + NGW : r; const size_t Ra = (size_t)hb * MH + r, Rb = (size_t)hb * MH + r2; const int ba = (int)(Ra >> 12), bb = (int)(Rb >> 12);
        f32x4 ya[4], yb[4], va[4], vb[4]; row_load_bf16(Y2 + (size_t)r * D, X.lane, ya); row_load_bf16(Y2 + (size_t)r2 * D, X.lane, yb); row_load_bf16(xs + (size_t)r * D, X.lane, va); row_load_bf16(xs + (size_t)r2 * D, X.lane, vb);
        float rya, ryb; row_rstd2(ya, yb, rya, ryb);
        const float* mva = mod + (((size_t)l * 2 + 1) * 8 + ba) * 3072; const float* mvb = mod + (((size_t)l * 2 + 1) * 8 + bb) * 3072;
#pragma unroll
        for (int j = 0; j < 4; ++j) { const int c = ROWCOL(X.lane, j); const f32x4 gg = *(const f32x4*)(fpost_g + l * D + c), gta = *(const f32x4*)(mva + 2048 + c), gtb = *(const f32x4*)(mvb + 2048 + c);
            va[j] = va[j] + gta * (ya[j] * rya * gg); vb[j] = vb[j] + gtb * (yb[j] * ryb * gg); }
        if (outf) {
#pragma unroll
            for (int j = 0; j < 4; ++j) { const int c = ROWCOL(X.lane, j); *(f32x4*)(outf + Ra * D + c) = va[j]; if (r2 != r) *(f32x4*)(outf + Rb * D + c) = vb[j]; }
        } else {
            row_store_x16(xd + (size_t)r * D, X.lane, va); if (r2 != r) row_store_x16(xd + (size_t)r2 * D, X.lane, vb);
            float ra, rb; row_rstd2(va, vb, ra, rb);
            row_modulate_store(va, ra, pre_g + (l + 1) * D, mod + (((size_t)(l + 1) * 2 + 0) * 8 + ba) * 3072, Hn + (size_t)r * D, nullptr, X.lane);
            if (r2 != r) row_modulate_store(vb, rb, pre_g + (l + 1) * D, mod + (((size_t)(l + 1) * 2 + 0) * 8 + bb) * 3072, Hn + (size_t)r2 * D, nullptr, X.lane); }
    }
}
__device__ __forceinline__ void upfix_panel(const Ctx& X_, const bf16_t* EDGE, const float* cw  , const float* cb  , bf16_t* ACT, int pm) {
    FRESH_CTX(X, X_);
    if ((pm & 15) == 0) return;
    for (int c = X.tid; c < DFF; c += 512) {
        const int pn = c >> 7, lc = c & 127;
        const bf16_t* e = EDGE + ((size_t)pm * 22 + pn) * 1024; const bf16_t* ep = EDGE + ((size_t)(pm - 1) * 22 + pn) * 1024 + 512;
        const float ga = h2f(e[lc]), gb_ = h2f(e[256 + lc]), va = h2f(e[128 + lc]), vb_ = h2f(e[256 + 128 + lc]);
        const float g2p = h2f(ep[lc]), g1p = h2f(ep[256 + lc]), v2p = h2f(ep[128 + lc]), v1p = h2f(ep[256 + 128 + lc]);
        const float wg0 = cw[c], wg1 = cw[DUP + c], wg2 = cw[2 * DUP + c], bg = cb[c], wv0 = cw[DFF + c], wv1 = cw[DUP + DFF + c], wv2 = cw[2 * DUP + DFF + c], bv = cb[DFF + c];
        const float gA = wg2 * ga + wg1 * g1p + wg0 * g2p + bg, vA = wv2 * va + wv1 * v1p + wv0 * v2p + bv;
        const float gB = wg2 * gb_ + wg1 * ga + wg0 * g1p + bg, vB = wv2 * vb_ + wv1 * va + wv0 * v1p + bv;
        ACT[((size_t)pm * 256) * DFF + c] = f2h(gelu_tanh(gA) * vA); ACT[((size_t)pm * 256 + 1) * DFF + c] = f2h(gelu_tanh(gB) * vB);
    }
}
__device__ __forceinline__ void phase_scans(const Ctx& X_, unsigned char* reg, const float* lam_re, const float* lam_im, const float* log_dt) {
    FRESH_CTX(X, X_);
    const bool s5w = X.wave == 7 && X.lane < 32;
    for (int wg = X.vcu; wg < 256; wg += X.G) {
        const int e = wg * 512 + X.tid;
        const int d = e & 63, ee = (e >> 6) & 127, bh = e >> 13, h = bh & 3, b = bh >> 2;
        const float* kv = (const float*)(reg + R_KVT) + (size_t)bh * 64 * 8192 + ee * 64 + d; const float* dc = (const float*)(reg + R_DEC) + (size_t)b * 64 * 256 + h * 64 + d;
        bf16_t* st = (bf16_t*)(reg + R_ST) + (size_t)bh * 64 * 8192 + ee * 64 + d;
        const int e5 = wg * 32 + (X.lane & 31); const int n5 = e5 & 63, g5 = (e5 >> 6) & 31, b5 = e5 >> 11;
        const float* sc5 = (const float*)(reg + R_S5SC) + ((size_t)g5 * 512 + b5 * 128) * 128 + n5; bf16_t* A5 = (bf16_t*)(reg + R_S5A) + ((size_t)g5 * 512 + b5 * 128) * S5K + 512 + n5;
        float ar = 0.f, ai = 0.f;
        if (s5w) { const float dt = expf(log_dt[g5]), lr = lam_re[g5 * 64 + n5], li = lam_im[g5 * 64 + n5]; const float mag = expf(lr * dt * 32.0f), ang = li * dt * 32.0f; ar = mag * cosf(ang); ai = mag * sinf(ang); }
        float S = 0.f, Sr = 0.f, Si = 0.f;
        for (int bt = 0; bt < 4; ++bt) { float kvv[16], dd[16];
#pragma unroll
            for (int q = 0; q < 16; ++q) { kvv[q] = kv[(size_t)(bt * 16 + q) * 8192]; dd[q] = dc[(size_t)(bt * 16 + q) * 256]; }
            if (s5w) { float xr[32], xi[32];
#pragma unroll
                for (int q = 0; q < 32; ++q) { xr[q] = sc5[(size_t)(bt * 32 + q) * 128]; xi[q] = sc5[(size_t)(bt * 32 + q) * 128 + 64]; }
#pragma unroll
                for (int q = 0; q < 32; ++q) { A5[(size_t)(bt * 32 + q) * S5K] = f2h(Sr); A5[(size_t)(bt * 32 + q) * S5K + 64] = f2h(Si);
                    const float nr = ar * Sr - ai * Si + xr[q], ni = ar * Si + ai * Sr + xi[q]; Sr = nr; Si = ni; } }
#pragma unroll
            for (int q = 0; q < 16; ++q) { st[(size_t)(bt * 16 + q) * 8192] = f2b(S); S = dd[q] * S + kvv[q]; } }
    }
}

__device__ __forceinline__ f32x16 mfma32(const bf16x8 a, const bf16x8 b, const f32x16 c) { return __builtin_amdgcn_mfma_f32_32x32x16_bf16(a, b, c, 0, 0, 0); }
__device__ __forceinline__ f32x16 zero16() { f32x16 z; for (int i = 0; i < 16; ++i) z[i] = 0.f; return z; }
__device__ __forceinline__ int crow(int r, int half) { return (r & 3) + 8 * (r >> 2) + 4 * half; }

__device__ __forceinline__ void gla_c1(const Ctx& X_, unsigned char* reg, const float* wgate, const float* bgate, int b, int ch) {
    FRESH_CTX(X, X_);
    LAS float* glrs = (LAS float*)X.lds; LAS float* tot = glrs + 1024;
    LAS bf16_t* ktT = (LAS bf16_t*)(X.lds + 8192); LAS bf16_t* vT = ktT + 4 * 64 * 72;
    const size_t row0 = (size_t)b * 4096 + (size_t)ch * 64; const size_t bc = (size_t)b * 64 + ch;
    const bf16_t* GQ = (const bf16_t*)(reg + R_GQ); const bf16_t* GK = (const bf16_t*)(reg + R_GK); const bf16_t* GV = (const bf16_t*)(reg + R_GV);
    __syncthreads();
    for (int i = X.tid; i < 1024; i += 512) glrs[i] = ((const float*)(reg + R_GLR))[row0 * 16 + i];
#pragma unroll
    for (int it = 0; it < 8; ++it) { const int tok = X.tid & 63, c8 = (it * 8 + (X.tid >> 6)) * 8; const u32x4 v = *(const u32x4*)(GV + (row0 + tok) * 512 + c8);
        LAS bf16_t* dst = vT + (size_t)c8 * 72 + tok;
#pragma unroll
        for (int q = 0; q < 4; ++q) { dst[(2 * q) * 72] = f2b(hlo(v[q])); dst[(2 * q + 1) * 72] = f2b(hhi(v[q])); } }
    __syncthreads();
    const int c = X.tid & 255, jh = X.tid >> 8, h = c >> 6, d = c & 63;
    float wg[16];
#pragma unroll
    for (int r = 0; r < 16; ++r) wg[r] = wgate[r * 256 + c];
    const float bg = bgate[c];
    unsigned short qraw[32], kraw[32];
#pragma unroll
    for (int jj = 0; jj < 32; ++jj) { qraw[jj] = GQ[(row0 + jh * 32 + jj) * 256 + c]; kraw[jj] = GK[(row0 + jh * 32 + jj) * 256 + c]; }
    float run = 0.f;
#pragma unroll 2
    for (int jj = 0; jj < 32; ++jj) { const int j = jh * 32 + jj; float x = bg;
#pragma unroll
        for (int r = 0; r < 16; ++r) x = fmaf(glrs[j * 16 + r], wg[r], x);
        run += (fminf(x, 0.f) - 0.6931471805599453f * __builtin_amdgcn_logf(1.0f + __builtin_amdgcn_exp2f(-1.4426950408889634f * fabsf(x)))) * 0.0625f; }
    tot[jh * 256 + c] = run;
    __syncthreads();
    const float last = tot[c] + tot[256 + c];
    float cumv = jh ? tot[c] : 0.f;
    bf16_t* QD = (bf16_t*)(reg + R_QD) + ((bc * 4 + h) * 64) * 64 + d; bf16_t* KI = (bf16_t*)(reg + R_KI) + ((bc * 4 + h) * 64) * 64 + d;
#pragma unroll
    for (int jj = 0; jj < 32; ++jj) { const int j = jh * 32 + jj; float x = bg;
#pragma unroll
        for (int r = 0; r < 16; ++r) x = fmaf(glrs[j * 16 + r], wg[r], x);
        cumv += (fminf(x, 0.f) - 0.6931471805599453f * __builtin_amdgcn_logf(1.0f + __builtin_amdgcn_exp2f(-1.4426950408889634f * fabsf(x)))) * 0.0625f;
        const float q = h2f(qraw[jj]), k = h2f(kraw[jj]);
        QD[(size_t)j * 64] = f2b(q * 0.125f * __expf(cumv)); KI[(size_t)j * 64] = f2b(k * __expf(-cumv));
        ktT[(h * 64 + d) * 72 + j] = f2b(k * __expf(last - cumv)); }
    if (jh == 1) ((float*)(reg + R_DEC))[bc * 256 + c] = expf(last);
    __syncthreads();
    bf16_t* VTg = (bf16_t*)(reg + R_VT) + bc * 512 * 64;
#pragma unroll
    for (int it = 0; it < 8; ++it) { const int idx = it * 512 + X.tid, row = idx >> 3, c16 = idx & 7; *(u32x4*)(VTg + (size_t)row * 64 + c16 * 8) = *(const LAS u32x4*)(vT + row * 72 + c16 * 8); }
    {
        const int hh = X.wave >> 1, half = X.lane >> 5, l31 = X.lane & 31;
        float* KVT = (float*)(reg + R_KVT) + (((size_t)b * 4 + hh) * 64 + ch) * 8192;
#pragma unroll
        for (int et = 0; et < 2; ++et)
#pragma unroll
            for (int dt2 = 0; dt2 < 2; ++dt2) { const int etile = 2 * (X.wave & 1) + et; f32x16 acc = zero16();
#pragma unroll
                for (int ks = 0; ks < 4; ++ks) { const bf16x8 a = *(const LAS bf16x8*)(vT + (hh * 128 + etile * 32 + l31) * 72 + ks * 16 + half * 8);
                    const bf16x8 bb = *(const LAS bf16x8*)(ktT + (hh * 64 + dt2 * 32 + l31) * 72 + ks * 16 + half * 8); acc = mfma32(a, bb, acc); }
#pragma unroll
                for (int r = 0; r < 16; ++r) KVT[(size_t)(etile * 32 + crow(r, half)) * 64 + dt2 * 32 + l31] = acc[r]; }
    }
}
__device__ __forceinline__ void gla_c3(const Ctx& X_, unsigned char* reg, const float* normg  , int b, int ch) {
    FRESH_CTX(X, X_);
    const int hh = X.wave >> 1, ih = X.wave & 1, half = X.lane >> 5, l31 = X.lane & 31; const size_t bc = (size_t)b * 64 + ch;
    const bf16_t* qd = (const bf16_t*)(reg + R_QD) + ((bc * 4 + hh) * 64) * 64; const bf16_t* ki = (const bf16_t*)(reg + R_KI) + ((bc * 4 + hh) * 64) * 64;
    const bf16_t* vt = (const bf16_t*)(reg + R_VT) + ((bc * 4 + hh) * 128) * 64; const bf16_t* st = (const bf16_t*)(reg + R_ST) + ((((size_t)b * 4 + hh) * 64 + ch) * 128) * 64;
    const size_t R = (size_t)b * 4096 + (size_t)ch * 64 + 32 * ih + l31;
    const bf16_t* GR = (const bf16_t*)(reg + R_GR) + R * 512 + hh * 128; bf16_t* YC = (bf16_t*)(reg + R_YS) + ((size_t)2 * MH + R) * 512 + hh * 128;
    bf16x8 qf[4], kf[2][4], sf[4][4];
#pragma unroll
    for (int ks = 0; ks < 4; ++ks) qf[ks] = *(const bf16x8*)(qd + (size_t)(32 * ih + l31) * 64 + ks * 16 + half * 8);
#pragma unroll
    for (int ks = 0; ks < 4; ++ks) kf[0][ks] = *(const bf16x8*)(ki + (size_t)l31 * 64 + ks * 16 + half * 8);
#pragma unroll
    for (int et = 0; et < 4; ++et)
#pragma unroll
        for (int ks = 0; ks < 4; ++ks) sf[et][ks] = *(const bf16x8*)(st + (size_t)(et * 32 + l31) * 64 + ks * 16 + half * 8);
    f32x16 o[4];
#pragma unroll
    for (int et = 0; et < 4; ++et) { o[et] = zero16();
#pragma unroll
        for (int ks = 0; ks < 4; ++ks) o[et] = mfma32(sf[et][ks], qf[ks], o[et]); }
#pragma unroll
    for (int et = 0; et < 4; ++et) asm volatile("" : "+v"(o[et]) :: "memory");
    u32x2 vlo[2][4][2], vhi[2][4][2], grr[4][4];
#pragma unroll
    for (int et = 0; et < 4; ++et)
#pragma unroll
        for (int sp = 0; sp < 2; ++sp) { const bf16_t* vp = vt + (size_t)(et * 32 + l31) * 64 + sp * 16 + half * 4; vlo[0][et][sp] = *(const u32x2*)vp; vhi[0][et][sp] = *(const u32x2*)(vp + 8); }
#pragma unroll
    for (int ks = 0; ks < 4; ++ks) kf[1][ks] = *(const bf16x8*)(ki + (size_t)(ih * 32 + l31) * 64 + ks * 16 + half * 8);
#pragma unroll
    for (int stl = 0; stl < 2; ++stl) if (stl <= ih) {
        f32x16 at = zero16();
#pragma unroll
        for (int ks = 0; ks < 4; ++ks) at = mfma32(kf[stl][ks], qf[ks], at);
        if (stl == ih) {
#pragma unroll
            for (int r = 0; r < 16; ++r) if (crow(r, half) > l31) at[r] = 0.f; }
        bf16x8 pf[2];
#pragma unroll
        for (int sp = 0; sp < 2; ++sp) { u32x4 w; w.x = pk2b(at[8 * sp + 0], at[8 * sp + 1]); w.y = pk2b(at[8 * sp + 2], at[8 * sp + 3]); w.z = pk2b(at[8 * sp + 4], at[8 * sp + 5]); w.w = pk2b(at[8 * sp + 6], at[8 * sp + 7]); pf[sp] = __builtin_bit_cast(bf16x8, w); }
#pragma unroll
        for (int et = 0; et < 4; ++et)
#pragma unroll
            for (int sp = 0; sp < 2; ++sp) { u32x4 w; w.x = vlo[stl][et][sp].x; w.y = vlo[stl][et][sp].y; w.z = vhi[stl][et][sp].x; w.w = vhi[stl][et][sp].y;
                o[et] = mfma32(__builtin_bit_cast(bf16x8, w), pf[sp], o[et]); }
        if (stl == 0) {
#pragma unroll
            for (int et = 0; et < 4; ++et) asm volatile("" : "+v"(o[et]) :: "memory");
#pragma unroll
            for (int et = 0; et < 4; ++et)
#pragma unroll
                for (int sp = 0; sp < 2; ++sp) { const bf16_t* vp = vt + (size_t)(et * 32 + l31) * 64 + ih * 32 + sp * 16 + half * 4; vlo[1][et][sp] = *(const u32x2*)vp; vhi[1][et][sp] = *(const u32x2*)(vp + 8); }
#pragma unroll
            for (int et = 0; et < 4; ++et)
#pragma unroll
                for (int g4 = 0; g4 < 4; ++g4) grr[et][g4] = *(const u32x2*)(GR + et * 32 + 8 * g4 + 4 * half); }
    }
    float ss = 0.f;
#pragma unroll
    for (int et = 0; et < 4; ++et)
#pragma unroll
        for (int r = 0; r < 16; ++r) ss += o[et][r] * o[et][r];
    ss += __shfl_xor(ss, 32);
    const float rstd = rsqrtf(ss * (1.0f / 128.0f) + EPS);
#pragma unroll
    for (int et = 0; et < 4; ++et) { f32x4 ngv[4];
#pragma unroll
        for (int g4 = 0; g4 < 4; ++g4) ngv[g4] = *(const f32x4*)(normg + hh * 128 + et * 32 + 8 * g4 + 4 * half);
#pragma unroll
        for (int g4 = 0; g4 < 4; ++g4) asm volatile("" : "+v"(ngv[g4]));
#pragma unroll
        for (int g4 = 0; g4 < 4; ++g4) { const int e0 = et * 32 + 8 * g4 + 4 * half; const f32x4 ng = ngv[g4]; const u32x2 rr = grr[et][g4];
            const float r0 = hlo(rr.x), r1 = hhi(rr.x), r2 = hlo(rr.y), r3 = hhi(rr.y);
            const float v0 = o[et][4 * g4 + 0] * rstd * ng[0] * (r0 * sigmoidf_(r0)), v1 = o[et][4 * g4 + 1] * rstd * ng[1] * (r1 * sigmoidf_(r1));
            const float v2 = o[et][4 * g4 + 2] * rstd * ng[2] * (r2 * sigmoidf_(r2)), v3 = o[et][4 * g4 + 3] * rstd * ng[3] * (r3 * sigmoidf_(r3));
            u32x2 w; w.x = pk2(v0, v1); w.y = pk2(v2, v3); *(u32x2*)(YC + e0) = w; } }
}

__device__ __forceinline__ unsigned f2key(float f) { const int u = __float_as_int(f); return (unsigned)(u ^ ((u >> 31) | (int)0x80000000)); }
__device__ __forceinline__ float key2f(unsigned k) { return __uint_as_float((k & 0x80000000u) ? (k & 0x7FFFFFFFu) : ~k); }
__device__ __forceinline__ f32x16 mfma32h(const bf16x8 a, const bf16x8 b, const f32x16 c) { return __builtin_amdgcn_mfma_f32_32x32x16_f16(__builtin_bit_cast(f16x8, a), __builtin_bit_cast(f16x8, b), c, 0, 0, 0); }
struct IkFrag { bf16x8 h0, h1, l0, l1; };
__device__ __forceinline__ IkFrag ik_load(const bf16_t* ikh_seq, const bf16_t* ikl_seq, int kt, int lane) {
    const size_t ko = (size_t)(kt * 32 + (lane & 31)) * 32 + (lane >> 5) * 8; IkFrag f;
    f.h0 = *(const bf16x8*)(ikh_seq + ko); f.h1 = *(const bf16x8*)(ikh_seq + ko + 16); if (DSA_TERMS >= 3) { f.l0 = *(const bf16x8*)(ikl_seq + ko); f.l1 = *(const bf16x8*)(ikl_seq + ko + 16); } else { f.l0 = f.h0; f.l1 = f.h1; } return f;
}
__device__ __forceinline__ f32x16 dsa_chain(const IkFrag& k, const bf16x8 qh0, const bf16x8 qh1, const bf16x8 ql0, const bf16x8 ql1) {
    f32x16 dd = zero16(); dd = mfma32h(k.h0, qh0, dd); dd = mfma32h(k.h1, qh1, dd); if (DSA_TERMS >= 2) { dd = mfma32h(k.h0, ql0, dd); dd = mfma32h(k.h1, ql1, dd); }
    if (DSA_TERMS >= 3) { dd = mfma32h(k.l0, qh0, dd); dd = mfma32h(k.l1, qh1, dd); }
    return dd;
}
__device__ __forceinline__ void dsa_accum(const f32x16& dd, float wh, float (&sc)[16]) {
#pragma unroll
    for (int r = 0; r < 16; ++r) { const float dv = dd[r]; sc[r] = fmaf(__builtin_fabsf(dv), wh, sc[r]); }
#pragma unroll
    for (int r = 0; r < 16; ++r) asm volatile("" : "+v"(sc[r]));
}
__device__ __forceinline__ void dsa_scores(const IkFrag& k, const bf16x8 (&qh)[8][2], const bf16x8 (&qt)[2]  , const LAS bf16x8* qlo, const float (&w)[8]  , float (&sc)[16]) {
    { f32x16 lin = zero16(); lin = mfma32h(k.h0, qt[0], lin); lin = mfma32h(k.h1, qt[1], lin);
#pragma unroll
      for (int r = 0; r < 16; ++r) sc[r] = lin[r]; }
    f32x16 da = dsa_chain(k, qh[0][0], qh[0][1], DSA_TERMS >= 2 ? qlo[0] : qh[0][0], DSA_TERMS >= 2 ? qlo[64] : qh[0][1]);
#pragma unroll
    for (int h = 0; h < 8; h += 2) {
        const f32x16 db = dsa_chain(k, qh[h + 1][0], qh[h + 1][1], DSA_TERMS >= 2 ? qlo[((h + 1) * 2 + 0) * 64] : qh[h + 1][0], DSA_TERMS >= 2 ? qlo[((h + 1) * 2 + 1) * 64] : qh[h + 1][1]);
        dsa_accum(da, w[h], sc);
        if (h + 2 < 8) da = dsa_chain(k, qh[h + 2][0], qh[h + 2][1], DSA_TERMS >= 2 ? qlo[((h + 2) * 2 + 0) * 64] : qh[h + 2][0], DSA_TERMS >= 2 ? qlo[((h + 2) * 2 + 1) * 64] : qh[h + 2][1]);
        dsa_accum(db, w[h + 1], sc);
    }
}
constexpr int DSA_SEL_OFF = 32 * 1025 * 4;
__device__ __forceinline__ void dsa_pick_bin(const LAS unsigned* hist, LAS unsigned* seg, LAS unsigned* sel_b1, LAS unsigned* sel_rem, LAS unsigned* sel_cnt, int tid, int level, LAS unsigned* big) {
    const int q = tid & 31, j = tid >> 5; const unsigned need = level ? sel_rem[q] : 256u;
    const LAS unsigned* hq = hist + (64 * j) * 32 + q; unsigned s = 0;
#pragma unroll 8
    for (int i = 0; i < 64; ++i) s += hq[i * 32];
    seg[j * 32 + q] = s;
    __syncthreads();
    unsigned above = 0;
    for (int k = j + 1; k < 16; ++k) above += seg[k * 32 + q];
    if (above < need && above + s >= need) { seg[512 + q] = (unsigned)j; seg[544 + q] = above; }
    __syncthreads();
    const unsigned jj = seg[512 + q], abv = seg[544 + q];
    const LAS unsigned* hs = hist + (64 * jj + 4 * j) * 32 + q; unsigned c4[4]; unsigned s4 = 0;
#pragma unroll
    for (int i = 0; i < 4; ++i) { c4[i] = hs[i * 32]; s4 += c4[i]; }
    seg[576 + j * 32 + q] = s4;
    __syncthreads();
    unsigned ab4 = abv;
    for (int k = j + 1; k < 16; ++k) ab4 += seg[576 + k * 32 + q];
    if (ab4 < need && ab4 + s4 >= need) {
        unsigned run = ab4; unsigned b1 = 0, rem = 1, cb = 0; bool found = false;
#pragma unroll
        for (int i = 3; i >= 0; --i) if (!found) { if (run + c4[i] >= need) { b1 = (unsigned)(64 * jj + 4 * j + i); rem = need - run; cb = c4[i]; found = true; } else run += c4[i]; }
        sel_b1[q] = level ? ((sel_b1[q] << 10) | b1) : b1; sel_rem[q] = rem; sel_cnt[q] = 0u;
        if (big != nullptr && cb > 256u) *big = 1u;
    }
}
__device__ __forceinline__ void dsa_bit_ge(unsigned& bits, float t, float thr) { asm("v_cmp_ge_f32 vcc, %1, %2\n\tv_addc_co_u32 %0, vcc, %0, %0, vcc" : "+v"(bits) : "v"(t), "v"(thr) : "vcc"); }
#define DSA_BITS2(GT, EQ, A_OF_R, B)  do { GT = 0u; EQ = 0u; _Pragma("unroll") for (int r_ = 15; r_ >= 0; --r_) { const auto a_ = (A_OF_R(r_)); GT = GT + GT + (unsigned)(a_ > (B)); EQ = EQ + EQ + (unsigned)(a_ == (B)); } } while (0)
__device__ __forceinline__ int dsa_mask_unit(const Ctx& X_, unsigned char* reg, int bl, int qb) {
    FRESH_CTX(X, X_);
    OPAQUE_GPTR(reg);
    const int lane = X.lane, wave = X.wave, half = lane >> 5, ql = lane & 31;
    const int t0 = qb * 32, nkt = qb + 1; const size_t seq0 = (size_t)bl * 4096;
    LAS unsigned* hist = (LAS unsigned*)X.lds; LAS unsigned long long* cand = (LAS unsigned long long*)X.lds;
    LAS unsigned* sel_b1 = (LAS unsigned*)(X.lds + DSA_SEL_OFF); LAS unsigned* sel_rem = sel_b1 + 32; LAS unsigned* sel_cnt = sel_rem + 32;
    LAS unsigned long long* sel_thr = (LAS unsigned long long*)(X.lds + DSA_SEL_OFF + 512);
    LAS bf16x8* qlo_lds = (LAS bf16x8*)(X.lds + DSA_SEL_OFF + 1024);
    LAS unsigned* seg = (LAS unsigned*)(X.lds + DSA_SEL_OFF + 1024 + 16384);
    LAS int* slot = (LAS int*)(X.lds + DSA_SEL_OFF + 400); unsigned* qctr = (unsigned*)(reg - WS_REG + WS_CTL) + CW_DSAQ;
    const bf16_t* IKH = (const bf16_t*)(reg + R_IKH) + seq0 * 32; const bf16_t* IKL = (const bf16_t*)(reg + R_IKL) + seq0 * 32;
    unsigned* MB = (unsigned*)(reg + R_MASK) + (((size_t)bl * 128 + qb) * 128) * 64 + lane;
    const size_t qrow = seq0 + t0 + ql; const int tq = t0 + ql;
    __syncthreads();
    if (qb < 8) {
        for (int kt = wave; kt < nkt; kt += 8) { unsigned bits = 0u;
#pragma unroll
            for (int r = 0; r < 16; ++r) if (kt * 32 + crow(r, half) <= tq) bits |= 1u << r;
            MB[(size_t)kt * 64] = bits; }
        if (X.tid == 0) slot[0] = (int)atomicAdd(qctr, 1u);
        __syncthreads();
        return slot[0];
    }
    float w[8]; { const f32x4 a = *(const f32x4*)((const float*)(reg + R_IW) + qrow * 8), b = *(const f32x4*)((const float*)(reg + R_IW) + qrow * 8 + 4);
        w[0] = a[0]; w[1] = a[1]; w[2] = a[2]; w[3] = a[3]; w[4] = b[0]; w[5] = b[1]; w[6] = b[2]; w[7] = b[3]; }
    const LAS bf16x8* qlo = qlo_lds + half * 32 + ql;
    const bf16_t* iqhrow = (const bf16_t*)(reg + R_IQH) + qrow * 256 + half * 8;
    bf16x8 qfh[8][2];
#pragma unroll
    for (int h = 0; h < 8; ++h)
#pragma unroll
        for (int s = 0; s < 2; ++s) qfh[h][s] = *(const bf16x8*)(iqhrow + h * 32 + s * 16);
    bf16x8 qt[2];
#pragma unroll
    for (int h = 0; h < 8; ++h) w[h] *= 0.5f;
#pragma unroll
    for (int s = 0; s < 2; ++s) { float a8[8];
#pragma unroll
        for (int j = 0; j < 8; ++j) a8[j] = 0.f;
#pragma unroll
        for (int h = 0; h < 8; ++h) { const u32x4 qv = __builtin_bit_cast(u32x4, qfh[h][s]);
            a8[0] += w[h] * hlo(qv.x); a8[1] += w[h] * hhi(qv.x); a8[2] += w[h] * hlo(qv.y); a8[3] += w[h] * hhi(qv.y); a8[4] += w[h] * hlo(qv.z); a8[5] += w[h] * hhi(qv.z); a8[6] += w[h] * hlo(qv.w); a8[7] += w[h] * hhi(qv.w); }
        u32x4 o; o.x = pk2(a8[0], a8[1]); o.y = pk2(a8[2], a8[3]); o.z = pk2(a8[4], a8[5]); o.w = pk2(a8[6], a8[7]); qt[s] = __builtin_bit_cast(bf16x8, o); }
    {
#pragma unroll
        for (int it = 0; it < 2; ++it) { const int idx = it * 512 + X.tid, q = idx >> 5, c8 = idx & 31;
            if (DSA_TERMS >= 2) qlo_lds[c8 * 32 + q] = *(const bf16x8*)((const bf16_t*)(reg + R_IQL) + (seq0 + t0 + q) * 256 + c8 * 8); }
    }
    LAS float* stat = (LAS float*)(X.lds + DSA_SEL_OFF + 768);
    if (X.tid < 64) stat[X.tid] = 0.f;
    if (X.tid < 2) { unsigned z = 0u; asm volatile("" : "+v"(z)); sel_b1[96 + X.tid] = z; }
    for (int i = X.tid; i < 32 * 1024; i += 512) hist[i] = 0u;
    unsigned cmask = 0u;
#pragma unroll
    for (int r = 0; r < 16; ++r) cmask |= (crow(r, half) <= ql) ? (1u << r) : 0u;
    __syncthreads();
    {
        const IkFrag f = ik_load(IKH, IKL, (wave * nkt) >> 3, lane); float sc[16]; dsa_scores(f, qfh, qt, qlo, w, sc); float s1 = 0.f, s2 = 0.f;
#pragma unroll
        for (int r = 0; r < 16; ++r) { s1 += sc[r]; s2 += sc[r] * sc[r]; }
        s1 += __shfl_xor(s1, 32); s2 += __shfl_xor(s2, 32);
        if (half == 0) { __hip_atomic_fetch_add(&stat[2 * ql], s1, __ATOMIC_RELAXED, __HIP_MEMORY_SCOPE_WORKGROUP); __hip_atomic_fetch_add(&stat[2 * ql + 1], s2, __ATOMIC_RELAXED, __HIP_MEMORY_SCOPE_WORKGROUP); }
    }
    __syncthreads();
    float lin_c0, lin_inv; { const float mean = stat[2 * ql] * (1.0f / 256.0f); const float var = fmaxf(stat[2 * ql + 1] * (1.0f / 256.0f) - mean * mean, 1e-30f); const float sd = sqrtf(var);
        lin_inv = (1024.0f / 12.0f) / sd; lin_c0 = -(mean - 6.0f * sd) * lin_inv; }
#define DSA_LINBIN(r) ((int)__builtin_amdgcn_fmed3f(__builtin_fmaf(sc[r], lin_inv, lin_c0), 0.f, 1023.f))
    LAS unsigned* hq_lane = hist + ql;
    {   IkFrag cur = ik_load(IKH, IKL, wave < nkt ? wave : 0, lane);
        for (int kt = wave; kt < nkt; kt += 8) { const IkFrag nxt = ik_load(IKH, IKL, kt + 8 < nkt ? kt + 8 : kt, lane);
            float sc[16]; dsa_scores(cur, qfh, qt, qlo, w, sc);
            if (kt != qb) {
#pragma unroll
                for (int r = 0; r < 16; ++r) __hip_atomic_fetch_add(&hq_lane[DSA_LINBIN(r) * 32], 1u, __ATOMIC_RELAXED, __HIP_MEMORY_SCOPE_WORKGROUP);
            } else {
#pragma unroll
                for (int r = 0; r < 16; ++r) if ((cmask >> r) & 1u) __hip_atomic_fetch_add(&hq_lane[DSA_LINBIN(r) * 32], 1u, __ATOMIC_RELAXED, __HIP_MEMORY_SCOPE_WORKGROUP);
            }
            cur = nxt; }
    }
    __syncthreads();
    dsa_pick_bin(hist, seg, sel_b1, sel_rem, sel_cnt, X.tid, 0, sel_b1 + 96);
    __syncthreads();
    const bool fast = sel_b1[96] == 0u;
    unsigned* MBQ = (unsigned*)(reg + R_MASK) + (((size_t)bl * 128 + qb) * 128) * 64;
    if (fast) {
        const int pref = (int)sel_b1[ql];
        const float f0 = pref == 0 ? -__builtin_inff() : (float)pref, f1 = pref == 1023 ? __builtin_inff() : (float)(pref + 1);
        IkFrag cur = ik_load(IKH, IKL, wave < nkt ? wave : 0, lane);
        for (int kt = wave; kt < nkt; kt += 8) { const IkFrag nxt = ik_load(IKH, IKL, kt + 8 < nkt ? kt + 8 : kt, lane);
            float sc[16]; dsa_scores(cur, qfh, qt, qlo, w, sc); unsigned ge0 = 0u, ge1 = 0u;
#pragma unroll
            for (int r = 15; r >= 0; --r) { const float t = __builtin_fmaf(sc[r], lin_inv, lin_c0); dsa_bit_ge(ge0, t, f0); dsa_bit_ge(ge1, t, f1); }
            unsigned gt = ge1, eq = ge0 & ~ge1;
            if (kt == qb) { gt &= cmask; eq &= cmask; }
            MB[(size_t)kt * 64] = gt;
            if (eq != 0u) {
#pragma unroll
                for (int r = 0; r < 16; ++r) if ((eq >> r) & 1u) { const unsigned pos = __hip_atomic_fetch_add(&sel_cnt[ql], 1u, __ATOMIC_RELAXED, __HIP_MEMORY_SCOPE_WORKGROUP);
                    if (pos < 256u) cand[ql * 256 + pos] = ((unsigned long long)f2key(sc[r]) << 32) | (unsigned long long)(0xFFFFFFFFu - (unsigned)(kt * 32 + crow(r, half))); } }
            cur = nxt; }
    } else {
        for (int level = 0; level < 2; ++level) {
            for (int i = X.tid; i < 32 * 1024; i += 512) hist[i] = 0u;
            __syncthreads();
            const unsigned pref = level ? sel_b1[ql] : 0u;
            IkFrag cur = ik_load(IKH, IKL, wave < nkt ? wave : 0, lane);
            for (int kt = wave; kt < nkt; kt += 8) { const IkFrag nxt = ik_load(IKH, IKL, kt + 8 < nkt ? kt + 8 : kt, lane);
                float sc[16]; dsa_scores(cur, qfh, qt, qlo, w, sc);
                const unsigned live = kt == qb ? cmask : 0xFFFFu;
#pragma unroll
                for (int r = 0; r < 16; ++r) { const unsigned key = f2key(sc[r]); const bool hit = ((live >> r) & 1u) && (level == 0 || (key >> 22) == pref);
                    if (hit) __hip_atomic_fetch_add(&hq_lane[(level ? ((key >> 12) & 1023u) : (key >> 22)) * 32], 1u, __ATOMIC_RELAXED, __HIP_MEMORY_SCOPE_WORKGROUP); }
                cur = nxt; }
            __syncthreads();
            dsa_pick_bin(hist, seg, sel_b1, sel_rem, sel_cnt, X.tid, level, nullptr);
            __syncthreads();
        }
        const unsigned pref = sel_b1[ql];
        IkFrag cur = ik_load(IKH, IKL, wave < nkt ? wave : 0, lane);
        for (int kt = wave; kt < nkt; kt += 8) { const IkFrag nxt = ik_load(IKH, IKL, kt + 8 < nkt ? kt + 8 : kt, lane);
            float sc[16]; dsa_scores(cur, qfh, qt, qlo, w, sc); unsigned gt, eq;
#define DSA_K20(r) (f2key(sc[r]) >> 12)
            DSA_BITS2(gt, eq, DSA_K20, pref);
            if (kt == qb) { gt &= cmask; eq &= cmask; }
            MB[(size_t)kt * 64] = gt;
            if (eq != 0u) {
#pragma unroll
                for (int r = 0; r < 16; ++r) if ((eq >> r) & 1u) { const unsigned pos = __hip_atomic_fetch_add(&sel_cnt[ql], 1u, __ATOMIC_RELAXED, __HIP_MEMORY_SCOPE_WORKGROUP);
                    if (pos < 256u) cand[ql * 256 + pos] = ((unsigned long long)f2key(sc[r]) << 32) | (unsigned long long)(0xFFFFFFFFu - (unsigned)(kt * 32 + crow(r, half))); } }
            cur = nxt; }
    }
    if (X.tid == 0) slot[0] = (int)atomicAdd(qctr, 1u);
    asm volatile("s_waitcnt vmcnt(0)" ::: "memory");
    __syncthreads();
    {
        for (int qi = 0; qi < 4; ++qi) { const int q = wave * 4 + qi; const unsigned cnt = (unsigned)__builtin_amdgcn_readfirstlane((int)sel_cnt[q]), rem = (unsigned)__builtin_amdgcn_readfirstlane((int)sel_rem[q]);
            if (cnt > 256u) { if (lane == 0) { sel_thr[q] = (unsigned long long)(sel_b1[q] << 12) << 32; sel_b1[97] = 1u; } continue; }
            const LAS unsigned long long* cq = cand + q * 256;
            for (unsigned e0 = 0; e0 < cnt; e0 += 64u) { const unsigned e = e0 + (unsigned)lane; const unsigned long long ce = e < cnt ? cq[e] : ~0ull; unsigned rank = 0;
#pragma unroll 4
                for (unsigned c2 = 0; c2 < cnt; ++c2) rank += (cq[c2] > ce) ? 1u : 0u;
                if (e < cnt) {
                    if (rank + 1u == rem) sel_thr[q] = ce;
                    if (rank < rem) { const unsigned kidx = 0xFFFFFFFFu - (unsigned)(ce & 0xFFFFFFFFull); const unsigned rho = kidx & 31u, hf = (rho >> 2) & 1u, rr = (rho & 3u) + 4u * (rho >> 3);
                        __hip_atomic_fetch_or(MBQ + (size_t)(kidx >> 5) * 64 + hf * 32 + q, 1u << rr, __ATOMIC_RELAXED, __HIP_MEMORY_SCOPE_AGENT); } } } }
    }
    __syncthreads();
    if (sel_b1[97] != 0u) {
        const unsigned long long thr = sel_thr[ql]; const float thr_f = key2f((unsigned)(thr >> 32)); const unsigned thr_i = 0xFFFFFFFFu - (unsigned)(thr & 0xFFFFFFFFull);
        asm volatile("s_waitcnt vmcnt(0)" ::: "memory");
        IkFrag cur = ik_load(IKH, IKL, wave < nkt ? wave : 0, lane);
        for (int kt = wave; kt < nkt; kt += 8) { const IkFrag nxt = ik_load(IKH, IKL, kt + 8 < nkt ? kt + 8 : kt, lane);
            float sc[16]; dsa_scores(cur, qfh, qt, qlo, w, sc); unsigned bits = 0u;
#pragma unroll
            for (int r = 0; r < 16; ++r) { const unsigned kidx = (unsigned)(kt * 32 + crow(r, half)); const bool sel = (sc[r] > thr_f) || (sc[r] == thr_f && kidx <= thr_i); if (sel && (int)kidx <= tq) bits |= 1u << r; }
            MB[(size_t)kt * 64] = bits;
            cur = nxt; }
    }
#undef DSA_LINBIN
#undef DSA_K20
    return slot[0];
}
__device__ __forceinline__ void dsa_att_tile2(const LAS unsigned char* kb, const LAS unsigned char* vb0, const LAS unsigned char* vb1, int half, int ksw, int vsw0, int vsw1, unsigned bitsA, unsigned bitsB, const bf16x8 (&qf)[4],
                                              f32x16& O0, f32x16& O1, float& mu, float& l, bool& any) {
    bf16x8 kfA[4], kfB[4];
#pragma unroll
    for (int s_ = 0; s_ < 4; ++s_) { kfA[s_] = *(const LAS bf16x8*)(kb + (((s_ * 2 + half) ^ ksw) * 16)); kfB[s_] = *(const LAS bf16x8*)(kb + 4096 + (((s_ * 2 + half) ^ ksw) * 16)); }
    f32x16 sA, sB;
#pragma unroll
    for (int r = 0; r < 16; ++r) { sA[r] = ((bitsA >> r) & 1u) ? -mu : -__builtin_inff(); sB[r] = ((bitsB >> r) & 1u) ? -mu : -__builtin_inff(); }
#pragma unroll
    for (int s_ = 0; s_ < 4; ++s_) asm volatile("" : "+v"(kfA[s_]), "+v"(kfB[s_]));
#pragma unroll
    for (int s_ = 0; s_ < 4; ++s_) { sA = mfma32h(kfA[s_], qf[s_], sA); sB = mfma32h(kfB[s_], qf[s_], sB); }
    bf16x8 vf0[2][2], vf1[2][2];
#pragma unroll
    for (int sp = 0; sp < 2; ++sp) { vf0[sp][0] = *(const LAS bf16x8*)(vb0 + (((sp * 2 + half) ^ vsw0) * 16)); vf1[sp][0] = *(const LAS bf16x8*)(vb1 + (((sp * 2 + half) ^ vsw1) * 16));
        vf0[sp][1] = *(const LAS bf16x8*)(vb0 + 4096 + (((sp * 2 + half) ^ vsw0) * 16)); vf1[sp][1] = *(const LAS bf16x8*)(vb1 + 4096 + (((sp * 2 + half) ^ vsw1) * 16)); }
#pragma unroll
    for (int sp = 0; sp < 2; ++sp) asm volatile("" : "+v"(vf0[sp][0]), "+v"(vf1[sp][0]), "+v"(vf0[sp][1]), "+v"(vf1[sp][1]));
    float xA[16], xB[16]; float ps = 0.f;
#pragma unroll
    for (int r = 0; r < 16; ++r) { xA[r] = __builtin_amdgcn_exp2f(sA[r]); xB[r] = __builtin_amdgcn_exp2f(sB[r]); ps += xA[r] + xB[r]; }
    if (!__all(ps <= 256.0f && (any || ps == 0.f))) {
        float mx = -__builtin_inff();
#pragma unroll
        for (int r = 0; r < 16; ++r) mx = fmaxf(mx, fmaxf(sA[r], sB[r]));
        const float dq = fmaxf(mx, __shfl_xor(mx, 32)); const bool fin = dq > -__builtin_inff();
        const float delta = any ? fmaxf(dq, 0.f) : (fin ? dq : 0.f);
        const float alpha = __builtin_amdgcn_exp2f(-delta);
        O0 *= alpha; O1 *= alpha; l *= alpha; mu += delta; any = any || fin;
        ps = 0.f;
#pragma unroll
        for (int r = 0; r < 16; ++r) { xA[r] = __builtin_amdgcn_exp2f(sA[r] - delta); xB[r] = __builtin_amdgcn_exp2f(sB[r] - delta); ps += xA[r] + xB[r]; }
    }
    l += ps;
    bf16x8 pA[2], pB[2];
#pragma unroll
    for (int sp = 0; sp < 2; ++sp) { u32x4 wv; wv.x = pk2(xA[8 * sp + 0], xA[8 * sp + 1]); wv.y = pk2(xA[8 * sp + 2], xA[8 * sp + 3]); wv.z = pk2(xA[8 * sp + 4], xA[8 * sp + 5]); wv.w = pk2(xA[8 * sp + 6], xA[8 * sp + 7]); pA[sp] = __builtin_bit_cast(bf16x8, wv);
        u32x4 wu; wu.x = pk2(xB[8 * sp + 0], xB[8 * sp + 1]); wu.y = pk2(xB[8 * sp + 2], xB[8 * sp + 3]); wu.z = pk2(xB[8 * sp + 4], xB[8 * sp + 5]); wu.w = pk2(xB[8 * sp + 6], xB[8 * sp + 7]); pB[sp] = __builtin_bit_cast(bf16x8, wu); }
#pragma unroll
    for (int sp = 0; sp < 2; ++sp) { O0 = mfma32h(vf0[sp][0], pA[sp], O0); O1 = mfma32h(vf1[sp][0], pA[sp], O1); O0 = mfma32h(vf0[sp][1], pB[sp], O0); O1 = mfma32h(vf1[sp][1], pB[sp], O1); }
}
__device__ __forceinline__ void dsa_attn_unit(const Ctx& X_, unsigned char* reg, int bl, int hh, int qblk) {
    FRESH_CTX(X, X_);
    OPAQUE_GPTR(reg);
    const int lane = X.lane, wave = X.wave, half = lane >> 5, ql = lane & 31, tid = X.tid;
    const int qt = qblk * 8 + wave, npair = qblk * 4 + 4; const size_t seq0 = (size_t)bl * 4096; const size_t qrow = seq0 + (size_t)qt * 32 + ql;
    const bool isk = tid < 256; const int t2 = tid & 255; const int srow = isk ? (t2 >> 3) : (t2 >> 2), sc_ = isk ? (t2 & 7) : (t2 & 3);
    const bf16_t* ssrc = isk ? (const bf16_t*)(reg + R_AK) + (seq0 + srow) * 512 + hh * 64 + sc_ * 8 : (const bf16_t*)(reg + R_AVT) + ((size_t)bl * 8 + hh) * 128 * 2048 + srow * 32 + sc_ * 8;
    const size_t sstep = isk ? (size_t)32 * 512 : (size_t)2048;
    const int sdst = isk ? srow * 128 + ((sc_ ^ (srow & 7)) * 16) : 8192 + srow * 64 + ((sc_ ^ ((srow >> 2) & 3)) * 16);
    bf16x8 qf[4];
#pragma unroll
    for (int s = 0; s < 4; ++s) { const f16x8 qv = __builtin_bit_cast(f16x8, *(const bf16x8*)((const bf16_t*)(reg + R_AQ) + qrow * 512 + hh * 64 + s * 16 + half * 8)) * (_Float16)(0.125f * 1.4426950408889634f);
        qf[s] = __builtin_bit_cast(bf16x8, qv); }
    const unsigned* MB = (const unsigned*)(reg + R_MASK) + (((size_t)bl * 128 + qt) * 128) * 64 + lane;
    const LAS unsigned char* kb = X.lds + ql * 128; const LAS unsigned char* vb0 = X.lds + 8192 + ql * 64; const LAS unsigned char* vb1 = X.lds + 8192 + (32 + ql) * 64;
    const int ksw = ql & 7, vsw0 = (ql >> 2) & 3, vsw1 = ((32 + ql) >> 2) & 3;
    __syncthreads();
    bf16x8 sa0, sb0, sa1, sb1, sa2, sb2;
#define STG_LOAD(A, B, P) do { const size_t _p = (size_t)((P) < npair ? (P) : 0) * 2; A = *(const bf16x8*)(ssrc + _p * sstep); B = *(const bf16x8*)(ssrc + (_p + 1) * sstep); } while (0)
    { bf16x8 a, b; STG_LOAD(a, b, 0); *(LAS bf16x8*)(X.lds + sdst) = a; *(LAS bf16x8*)(X.lds + sdst + 4096) = b; }
    STG_LOAD(sa1, sb1, 1); STG_LOAD(sa2, sb2, 2); STG_LOAD(sa0, sb0, 3);
    unsigned mbA = MB[0], mbB = MB[64];
    f32x16 O0 = zero16(), O1 = zero16(); float mu = 0.f, l = 0.f; bool any = false;
    __syncthreads();
#define ATT_ITER(SA, SB) do { if (kp < npair) { const int cb = (kp & 1) * 16384, nb = ((kp + 1) & 1) * 16384; \
        if (kp + 1 < npair) { *(LAS bf16x8*)(X.lds + sdst + nb) = SA; *(LAS bf16x8*)(X.lds + sdst + nb + 4096) = SB; } \
        STG_LOAD(SA, SB, kp + 4); \
        if (2 * kp <= qt) { const unsigned bitsA = mbA, bitsB = (2 * kp + 1 <= qt) ? mbB : 0u; const int kn = 2 * kp + 2 <= qt ? 2 * kp + 2 : 2 * kp; mbA = MB[(size_t)kn * 64]; mbB = MB[(size_t)(kn + 1 <= qt ? kn + 1 : kn) * 64]; \
            dsa_att_tile2(kb + cb, vb0 + cb, vb1 + cb, half, ksw, vsw0, vsw1, bitsA, bitsB, qf, O0, O1, mu, l, any); } \
        __syncthreads(); } ++kp; } while (0)
    for (int kp = 0; kp < npair; ) { ATT_ITER(sa1, sb1); ATT_ITER(sa2, sb2); ATT_ITER(sa0, sb0); }
#undef ATT_ITER
#undef STG_LOAD
    l += __shfl_xor(l, 32);
    const float inv = 1.0f / l;
    bf16_t* YA = (bf16_t*)(reg + R_YS) + qrow * 512 + hh * 64;
#pragma unroll
    for (int g4 = 0; g4 < 4; ++g4) { const int d0 = 8 * g4 + 4 * half;
        u32x2 w0; w0.x = pk2(O0[4 * g4 + 0] * inv, O0[4 * g4 + 1] * inv); w0.y = pk2(O0[4 * g4 + 2] * inv, O0[4 * g4 + 3] * inv); *(u32x2*)(YA + d0) = w0;
        u32x2 w1; w1.x = pk2(O1[4 * g4 + 0] * inv, O1[4 * g4 + 1] * inv); w1.y = pk2(O1[4 * g4 + 2] * inv, O1[4 * g4 + 3] * inv); *(u32x2*)(YA + 32 + d0) = w1; }
}

#ifdef DBG_CHECKS
__device__ __forceinline__ unsigned dbg_hash(unsigned x) { x ^= x >> 16; x *= 0x7feb352du; x ^= x >> 15; x *= 0x846ca68bu; x ^= x >> 16; return x; }
__device__ __forceinline__ float dbg_dot_h(const bf16_t* a, const bf16_t* b, int K) { float s = 0.f; for (int k = 0; k < K; ++k) s += h2f(a[k]) * h2f(b[k]); return s; }
__device__ __forceinline__ void dbg_acc(float* dbg, int k, float got, float ref) { atomicAdd(&dbg[2 * k], (got - ref) * (got - ref)); atomicAdd(&dbg[2 * k + 1], ref * ref); }
__global__ void dbg_chk_proj(unsigned char* ws) {
    unsigned char* reg = ws + WS_REG; float* dbg = (float*)(ws + 512 * 1024);
    const unsigned sidx = blockIdx.x * blockDim.x + threadIdx.x; const unsigned h1 = dbg_hash(sidx * 2 + 1), h2 = dbg_hash(sidx * 2 + 2);
    const size_t row = h1 % MH; const bf16_t* H = (const bf16_t*)(reg + R_H) + row * D; const bf16_t* HL = (const bf16_t*)(reg + R_HLO) + row * D; const bf16_t* W = (const bf16_t*)(ws + WS_WIN);
    { const int col = h2 % 512; dbg_acc(dbg, 0, h2f(((const bf16_t*)(reg + R_AQ))[row * 512 + col]), dbg_dot_h(H, W + (size_t)col * D, D)); }
    { const int col = h2 % 512; dbg_acc(dbg, 1, h2f(((const bf16_t*)(reg + R_AK))[row * 512 + col]), dbg_dot_h(H, W + (size_t)(512 + col) * D, D)); }
    { const int col = h2 % 512; const size_t b = row >> 12, t = row & 4095; dbg_acc(dbg, 2, h2f(((const bf16_t*)(reg + R_AVT))[avt_index(b, col, t)]), dbg_dot_h(H, W + (size_t)(1024 + col) * D, D)); }
    { const int col = h2 % 256; const bf16_t* WL = (const bf16_t*)(ws + WS_WINLO) + (size_t)col * D; const bf16_t* Wc = W + (size_t)(1536 + col) * D; float r = 0.f;
      for (int k = 0; k < D; ++k) r += (h2f(H[k]) + h2f(HL[k])) * (h2f(Wc[k]) + h2f(WL[k]));
      dbg_acc(dbg, 3, h2f(((const bf16_t*)(reg + R_IQH))[row * 256 + col]) + h2f(((const bf16_t*)(reg + R_IQL))[row * 256 + col]), r); }
    { const int col = h2 % 32; const bf16_t* WL = (const bf16_t*)(ws + WS_WINLO) + (size_t)(256 + col) * D; const bf16_t* Wc = W + (size_t)(1792 + col) * D; float r = 0.f;
      for (int k = 0; k < D; ++k) r += (h2f(H[k]) + h2f(HL[k])) * (h2f(Wc[k]) + h2f(WL[k]));
      dbg_acc(dbg, 4, h2f(((const bf16_t*)(reg + R_IKH))[row * 32 + col]) + h2f(((const bf16_t*)(reg + R_IKL))[row * 32 + col]), r); }
    { const int col = h2 % 8; const bf16_t* WL = (const bf16_t*)(ws + WS_WINLO) + (size_t)(256 + 32 + col) * D; const bf16_t* Wc = W + (size_t)(1792 + 32 + col) * D; float r = 0.f;
      for (int k = 0; k < D; ++k) r += (h2f(H[k]) + h2f(HL[k])) * (h2f(Wc[k]) + h2f(WL[k]));
      dbg_acc(dbg, 5, ((const float*)(reg + R_IW))[row * 8 + col], r * 0.0625f); }
    { const int col = h2 % 16; const bf16_t* WL = (const bf16_t*)(ws + WS_WINLO) + (size_t)(256 + 40 + col) * D; const bf16_t* Wc = W + (size_t)(1792 + 40 + col) * D; float r = 0.f;
      for (int k = 0; k < D; ++k) r += (h2f(H[k]) + h2f(HL[k])) * (h2f(Wc[k]) + h2f(WL[k]));
      dbg_acc(dbg, 6, ((const float*)(reg + R_GLR))[row * 16 + col], r); }
    { const int col = h2 % 512; const size_t b = row >> 12, t = row & 4095, g = col >> 4, p = col & 15; dbg_acc(dbg, 7, h2f(((const bf16_t*)(reg + R_S5A))[(g * 512 + b * 128 + (t >> 5)) * S5K + (t & 31) * 16 + p]), dbg_dot_h(H, W + (size_t)(2048 + col) * D, D)); }
    { const int col = h2 % 256; dbg_acc(dbg, 8, h2f(((const bf16_t*)(reg + R_GQ))[row * 256 + col]), dbg_dot_h(H, W + (size_t)(2560 + col) * D, D)); }
    { const int col = h2 % 256; dbg_acc(dbg, 9, h2f(((const bf16_t*)(reg + R_GK))[row * 256 + col]), dbg_dot_h(H, W + (size_t)(2816 + col) * D, D)); }
    { const int col = h2 % 512; dbg_acc(dbg, 10, h2f(((const bf16_t*)(reg + R_GV))[row * 512 + col]), dbg_dot_h(H, W + (size_t)(3072 + col) * D, D)); }
    { const int col = h2 % 512; dbg_acc(dbg, 11, h2f(((const bf16_t*)(reg + R_GR))[row * 512 + col]), dbg_dot_h(H, W + (size_t)(3584 + col) * D, D)); }
    { const int col = h2 % 3072; const float z = dbg_dot_h(H, W + (size_t)(4096 + col) * D, D); dbg_acc(dbg, 12, h2f(((const bf16_t*)(reg + R_GATES))[((size_t)(col >> 10) * MH + row) * D + (col & 1023)]), 1.0f / (1.0f + expf(-z))); }
}
__global__ void dbg_chk_w(unsigned char* ws, const float* w_in, const float* w_glu, const float* w_br, const float* w_out, const float* w_up, const float* w_dn) {
    float* dbg = (float*)(ws + 512 * 1024); const unsigned sidx = blockIdx.x * blockDim.x + threadIdx.x; const unsigned h1 = dbg_hash(sidx * 2 + 11), h2 = dbg_hash(sidx * 2 + 12);
    { const int n = h1 % NPROJ, k = h2 % D; const int sc = MapWin()(n); dbg_acc(dbg, 13, h2f(((const bf16_t*)(ws + WS_WIN))[(size_t)n * D + k]), sc >= 0 ? w_in[(size_t)k * D_IN + sc] : 0.f); }
    { const int n = h1 % 1024, k = h2 % 512; dbg_acc(dbg, 14, h2f(((const bf16_t*)(ws + WS_WGLU))[(size_t)n * 512 + k]), w_glu[(size_t)k * 1024 + MapGlu()(n)]); }
    { const int n = h1 % 3072, k = h2 % 512; dbg_acc(dbg, 15, h2f(((const bf16_t*)(ws + WS_WBR))[(size_t)n * 512 + k]), w_br[((size_t)(n >> 10) * 512 + k) * 1024 + (n & 1023)]); }
    { const int n = h1 % 1024, k = h2 % 1024; dbg_acc(dbg, 16, h2f(((const bf16_t*)(ws + WS_WOUT))[(size_t)n * D + k]), w_out[(size_t)k * D + n]); }
    { const int n = h1 % DUP, k = h2 % 1024; dbg_acc(dbg, 17, h2f(((const bf16_t*)(ws + WS_WUP))[(size_t)n * D + k]), w_up[(size_t)k * DUP + n]); }
    { const int n = h1 % 1024, k = h2 % DFF; dbg_acc(dbg, 18, h2f(((const bf16_t*)(ws + WS_WDN))[(size_t)n * DFF + k]), w_dn[(size_t)k * D + n]); }
}
__global__ void dbg_chk_glu(unsigned char* ws) {
    unsigned char* reg = ws + WS_REG; float* dbg = (float*)(ws + 512 * 1024); const unsigned sidx = blockIdx.x * blockDim.x + threadIdx.x; const unsigned h1 = dbg_hash(sidx * 2 + 21), h2 = dbg_hash(sidx * 2 + 22);
    const size_t row = h1 % MH; const int col = h2 % 512; const bf16_t* A = (const bf16_t*)(reg + R_GACT) + row * 512; const bf16_t* W = (const bf16_t*)(ws + WS_WGLU);
    const int pn = col >> 7, c = col & 127; const float ga = dbg_dot_h(A, W + (size_t)(pn * 256 + c) * 512, 512), gb = dbg_dot_h(A, W + (size_t)(pn * 256 + 128 + c) * 512, 512);
    dbg_acc(dbg, 19, h2f(((const bf16_t*)(reg + R_YS))[((size_t)MH + row) * 512 + col]), ga / (1.0f + expf(-gb)));
}
__global__ void dbg_chk_merge(unsigned char* ws) {
    unsigned char* reg = ws + WS_REG; float* dbg = (float*)(ws + 512 * 1024); const unsigned sidx = blockIdx.x * blockDim.x + threadIdx.x; const unsigned h1 = dbg_hash(sidx * 2 + 31), h2 = dbg_hash(sidx * 2 + 32);
    const size_t row = h1 % MH; const int col = h2 % D; float r = 0.f;
    for (int i = 0; i < 3; ++i) r += h2f(((const bf16_t*)(reg + R_GATES))[((size_t)i * MH + row) * D + col]) * dbg_dot_h((const bf16_t*)(reg + R_YS) + ((size_t)i * MH + row) * 512, (const bf16_t*)(ws + WS_WBR) + ((size_t)i * 1024 + col) * 512, 512);
    dbg_acc(dbg, 20, h2f(((const bf16_t*)(reg + R_H))[row * D + col]), r);
}
__global__ void dbg_chk_gemm(unsigned char* ws, int k, size_t a_off, int lda, size_t b_off, int K, size_t o_off, int ldo, int N) {
    unsigned char* reg = ws + WS_REG; float* dbg = (float*)(ws + 512 * 1024); const unsigned sidx = blockIdx.x * blockDim.x + threadIdx.x; const unsigned h1 = dbg_hash(sidx * 2 + 41 + k), h2 = dbg_hash(sidx * 2 + 42 + k);
    const size_t row = h1 % MH; const int col = h2 % N;
    dbg_acc(dbg, k, h2f(((const bf16_t*)(reg + o_off))[row * ldo + col]), dbg_dot_h((const bf16_t*)(reg + a_off) + row * lda, (const bf16_t*)(ws + b_off) + (size_t)col * K, K));
}
__global__ void dbg_chk_act(unsigned char* ws, const float* cw, const float* cb) {
    unsigned char* reg = ws + WS_REG; float* dbg = (float*)(ws + 512 * 1024); const unsigned sidx = blockIdx.x * blockDim.x + threadIdx.x; const unsigned h1 = dbg_hash(sidx * 2 + 51), h2 = dbg_hash(sidx * 2 + 52);
    const size_t row = h1 % MH; const int c = h2 % DFF; const bf16_t* U = (const bf16_t*)(reg + R_U); const int t = (int)(row & 4095); float g = cb[c], v = cb[DFF + c];
    for (int j = 0; j < 3; ++j) { const int tt = t - 2 + j; if (tt >= 0) { g += cw[j * DUP + c] * h2f(U[(row - 2 + j) * DUP + c]); v += cw[j * DUP + DFF + c] * h2f(U[(row - 2 + j) * DUP + DFF + c]); } }
    const float ge = 0.5f * g * (1.0f + tanhf(0.7978845608f * (g + 0.044715f * g * g * g)));
    dbg_acc(dbg, 24, h2f(((const bf16_t*)(reg + R_ACT))[row * DFF + c]), ge * v);
}

__global__ void dbg_chk_dsa(unsigned char* ws) {
    unsigned char* reg = ws + WS_REG; float* dbg = (float*)(ws + 512 * 1024);
    __shared__ float sc[4096]; __shared__ int sel[256]; __shared__ int nsel; __shared__ float lg[8][256];
    const int tlist[12] = {5, 100, 255, 256, 300, 511, 777, 1500, 2047, 3000, 4000, 4095};
    const int bl = (blockIdx.x & 1) ? 3 : 0, t = tlist[blockIdx.x >> 1], tid = threadIdx.x; const size_t row = (size_t)bl * 4096 + t;
    const bf16_t* IQH = (const bf16_t*)(reg + R_IQH) + row * 256; const bf16_t* IQL = (const bf16_t*)(reg + R_IQL) + row * 256; const float* IW = (const float*)(reg + R_IW) + row * 8;
    for (int s = tid; s <= t; s += 256) { const bf16_t* kh = (const bf16_t*)(reg + R_IKH) + ((size_t)bl * 4096 + s) * 32; const bf16_t* kl = (const bf16_t*)(reg + R_IKL) + ((size_t)bl * 4096 + s) * 32; float acc = 0.f;
        for (int h = 0; h < 8; ++h) { float d = 0.f; for (int k = 0; k < 32; ++k) d += (h2f(IQH[h * 32 + k]) + h2f(IQL[h * 32 + k])) * (h2f(kh[k]) + h2f(kl[k])); acc += IW[h] * fmaxf(d, 0.f); }
        sc[s] = acc; }
    if (tid == 0) nsel = 0;
    __syncthreads();
    if ((bl == 0 && t == 300) || (bl == 3 && t == 4095)) for (int s2 = tid; s2 <= t; s2 += 256) dbg_acc(dbg, 38, ((const float*)(ws + 900 * 1024))[(bl ? 4096 : 0) + s2], sc[s2]);
    for (int s = tid; s <= t; s += 256) { int rank = 0; const float v = sc[s]; for (int s2 = 0; s2 <= t; ++s2) { const float v2 = sc[s2]; rank += (v2 > v || (v2 == v && s2 < s)) ? 1 : 0; }
        if (rank < 256) { const int p = atomicAdd(&nsel, 1); sel[p] = s; } }
    __syncthreads();
    if (t >= 256) for (int s2 = tid; s2 <= t; s2 += 256) { int rank = 0; const float v = sc[s2]; for (int s3 = 0; s3 <= t; ++s3) { const float v2 = sc[s3]; rank += (v2 > v || (v2 == v && s3 < s2)) ? 1 : 0; }
        if (rank == 255) { const unsigned long long thr = ((const unsigned long long*)(ws + 600 * 1024))[row]; const unsigned cnt = ((const unsigned*)(ws + 800 * 1024))[row];
            dbg_acc(dbg, 35, (float)cnt, 256.0f); dbg_acc(dbg, 36, (float)(0xFFFFFFFFu - (unsigned)(thr & 0xFFFFFFFFull)), (float)s2);
            const unsigned kf = (unsigned)(thr >> 32); const float tv = __uint_as_float((kf & 0x80000000u) ? (kf & 0x7FFFFFFFu) : ~kf); dbg_acc(dbg, 37, tv, v); } }
    __syncthreads();
    const int n = nsel;
    if (tid < n) { const int key = sel[tid]; for (int h = 0; h < 8; ++h) { float d = 0.f; for (int k = 0; k < 64; ++k) d += h2f(((const bf16_t*)(reg + R_AQ))[row * 512 + h * 64 + k]) * h2f(((const bf16_t*)(reg + R_AK))[((size_t)bl * 4096 + key) * 512 + h * 64 + k]); lg[h][tid] = d * 0.125f; } }
    __syncthreads();
    if (t >= 256) {
        const int h = tid >> 5, l32 = tid & 31; float mx = -1e30f, den = 0.f, o0 = 0.f, o1 = 0.f;
        for (int pass = 0; pass < 2; ++pass) for (int key = 0; key <= t; ++key) { float d = 0.f; for (int k = 0; k < 64; ++k) d += h2f(((const bf16_t*)(reg + R_AQ))[row * 512 + h * 64 + k]) * h2f(((const bf16_t*)(reg + R_AK))[((size_t)bl * 4096 + key) * 512 + h * 64 + k]); d *= 0.125f;
            if (pass == 0) mx = fmaxf(mx, d); else { const float p = expf(d - mx); den += p; o0 += p * h2f(((const bf16_t*)(reg + R_AVT))[avt_index(bl, h * 64 + l32 * 2, key)]); o1 += p * h2f(((const bf16_t*)(reg + R_AVT))[avt_index(bl, h * 64 + l32 * 2 + 1, key)]); } }
        dbg_acc(dbg, 34, h2f(((const bf16_t*)(reg + R_YS))[row * 512 + h * 64 + l32 * 2]), o0 / den); dbg_acc(dbg, 34, h2f(((const bf16_t*)(reg + R_YS))[row * 512 + h * 64 + l32 * 2 + 1]), o1 / den);
    }
    { const int h = tid >> 5, l32 = tid & 31; float mx = -1e30f; for (int j = 0; j < n; ++j) mx = fmaxf(mx, lg[h][j]); float den = 0.f; for (int j = 0; j < n; ++j) den += expf(lg[h][j] - mx);
      for (int q = 0; q < 2; ++q) { const int d = l32 * 2 + q; float o = 0.f; for (int j = 0; j < n; ++j) o += expf(lg[h][j] - mx) / den * h2f(((const bf16_t*)(reg + R_AVT))[avt_index(bl, h * 64 + d, sel[j])]);
          dbg_acc(dbg, (blockIdx.x >> 1) < 3 ? 25 : 31 + ((blockIdx.x >> 1) - 3) / 3, h2f(((const bf16_t*)(reg + R_YS))[row * 512 + h * 64 + d]), o); } }
}
__global__ void __launch_bounds__(128) dbg_chk_gla(unsigned char* ws, const float* wgate, const float* bgate, const float* normg) {
    unsigned char* reg = ws + WS_REG; float* dbg = (float*)(ws + 512 * 1024);
    __shared__ float a_s[64], q_s[64], k_s[64], red[128];
    const int bl = (blockIdx.x >> 2) ? 2 : 0, h = blockIdx.x & 3, e = threadIdx.x; float S[64];
#pragma unroll
    for (int d = 0; d < 64; ++d) S[d] = 0.f;
    for (int t = 0; t < 256; ++t) { const size_t row = (size_t)bl * 4096 + t;
        if (e < 64) { const int c = h * 64 + e; float x = bgate[c]; for (int r = 0; r < 16; ++r) x += ((const float*)(reg + R_GLR))[row * 16 + r] * wgate[r * 256 + c];
            const float ls = fminf(x, 0.f) - log1pf(expf(-fabsf(x))); a_s[e] = expf(ls / 16.0f); q_s[e] = h2f(((const bf16_t*)(reg + R_GQ))[row * 256 + c]) * 0.125f; k_s[e] = h2f(((const bf16_t*)(reg + R_GK))[row * 256 + c]); }
        __syncthreads();
        const float v = h2f(((const bf16_t*)(reg + R_GV))[row * 512 + h * 128 + e]); float o = 0.f;
#pragma unroll
        for (int d = 0; d < 64; ++d) { S[d] = a_s[d] * S[d] + k_s[d] * v; o += q_s[d] * S[d]; }
        red[e] = o * o; __syncthreads();
        for (int st = 64; st > 0; st >>= 1) { if (e < st) red[e] += red[e + st]; __syncthreads(); }
        const float rstd = rsqrtf(red[0] / 128.0f + EPS); const float r = h2f(((const bf16_t*)(reg + R_GR))[row * 512 + h * 128 + e]);
        dbg_acc(dbg, 26, h2f(((const bf16_t*)(reg + R_YS))[((size_t)2 * MH + row) * 512 + h * 128 + e]), o * rstd * normg[h * 128 + e] * (r / (1.0f + expf(-r))));
        __syncthreads(); }
}
__global__ void dbg_chk_s5(unsigned char* ws, const float* lam_re, const float* lam_im, const float* log_dt, const float* b_re, const float* b_im, const float* c_re, const float* c_im, const float* dsk) {
    unsigned char* reg = ws + WS_REG; float* dbg = (float*)(ws + 512 * 1024);
    __shared__ float xr_s[64], xi_s[64], u_s[16];
    const int glist[4] = {0, 7, 19, 31}; const int bl = (blockIdx.x >> 2) ? 3 : 0, g = glist[blockIdx.x & 3], n = threadIdx.x;
    const float dt = expf(log_dt[g]), lr = lam_re[g * 64 + n], li = lam_im[g * 64 + n], mag = expf(lr * dt), ar = mag * cosf(li * dt), ai = mag * sinf(li * dt), den = lr * lr + li * li, nr = ar - 1.0f, ni = ai;
    const float fr_ = (nr * lr + ni * li) / den, fi_ = (ni * lr - nr * li) / den; float xr = 0.f, xi = 0.f;
    for (int t = 0; t < 128; ++t) { const size_t row = (size_t)bl * 4096 + t;
        if (n < 16) u_s[n] = h2f(((const bf16_t*)(reg + R_S5A))[((size_t)g * 512 + bl * 128 + (t >> 5)) * S5K + (t & 31) * 16 + n]);
        __syncthreads();
        float bur = 0.f, bui = 0.f; for (int p = 0; p < 16; ++p) { const float br = b_re[((size_t)g * 64 + n) * 16 + p], bi = b_im[((size_t)g * 64 + n) * 16 + p]; bur += (fr_ * br - fi_ * bi) * u_s[p]; bui += (fr_ * bi + fi_ * br) * u_s[p]; }
        const float nxr = ar * xr - ai * xi + bur, nxi = ar * xi + ai * xr + bui; xr = nxr; xi = nxi; xr_s[n] = xr; xi_s[n] = xi;
        __syncthreads();
        if (n < 16) { float y = 0.f; for (int m = 0; m < 64; ++m) y += c_re[((size_t)g * 16 + n) * 64 + m] * xr_s[m] - c_im[((size_t)g * 16 + n) * 64 + m] * xi_s[m];
            y += dsk[g * 16 + n] * u_s[n]; const float ge = 0.5f * y * (1.0f + tanhf(0.7978845608f * (y + 0.044715f * y * y * y)));
            dbg_acc(dbg, 27, h2f(((const bf16_t*)(reg + R_GACT))[row * 512 + g * 16 + n]), ge); }
        __syncthreads(); }
}
__global__ void dbg_chk_t1(unsigned char* ws, const float* out, const float* c, const float* modw, const float* modb, const float* pre_g) {
    unsigned char* reg = ws + WS_REG; float* dbg = (float*)(ws + 512 * 1024); __shared__ float red[256];
    const size_t r = dbg_hash(blockIdx.x * 7 + 3) % MH, R = (size_t)MH + r; const int b = (int)(R >> 12), tid = threadIdx.x; const float* x = out + R * D;
    float s = 0.f; for (int k = tid; k < D; k += 256) s += x[k] * x[k]; red[tid] = s; __syncthreads();
    for (int st = 128; st > 0; st >>= 1) { if (tid < st) red[tid] += red[tid + st]; __syncthreads(); }
    const float rstd = rsqrtf(red[0] / 1024.0f + EPS);
    if (tid < 8) { const int col = dbg_hash(blockIdx.x * 8 + tid + 99) % D; float sh = modb[col], scl = modb[1024 + col];
        for (int k = 0; k < D; ++k) { const float cv = c[b * 1024 + k], sv = cv / (1.0f + expf(-cv)); sh += sv * modw[(size_t)k * 3072 + col]; scl += sv * modw[(size_t)k * 3072 + 1024 + col]; }
        const float ref = x[col] * rstd * pre_g[col] * (1.0f + scl) + sh;
        dbg_acc(dbg, 28, h2f(((const bf16_t*)(reg + R_H))[r * D + col]) + h2f(((const bf16_t*)(reg + R_HLO))[r * D + col]), ref); }
}
__global__ void dbg_chk_t2(unsigned char* ws, const float* xin, const float* out, const float* c, const float* mixw, const float* mixb, const float* ffnw, const float* ffnb, const float* post_g, const float* fpre_g) {
    unsigned char* reg = ws + WS_REG; float* dbg = (float*)(ws + 512 * 1024); __shared__ float red[256]; __shared__ float rs[2];
    const size_t r = dbg_hash(blockIdx.x * 5 + 1) % MH; const int b = (int)(r >> 12), tid = threadIdx.x; const bf16_t* y = (const bf16_t*)(reg + R_Y) + r * D;
    float s = 0.f; for (int k = tid; k < D; k += 256) { const float v = h2f(y[k]); s += v * v; } red[tid] = s; __syncthreads();
    for (int st = 128; st > 0; st >>= 1) { if (tid < st) red[tid] += red[tid + st]; __syncthreads(); }
    if (tid == 0) rs[0] = rsqrtf(red[0] / 1024.0f + EPS); __syncthreads();
    s = 0.f; for (int k = tid; k < D; k += 256) { const float v = out[r * D + k]; s += v * v; } red[tid] = s; __syncthreads();
    for (int st = 128; st > 0; st >>= 1) { if (tid < st) red[tid] += red[tid + st]; __syncthreads(); }
    if (tid == 0) rs[1] = rsqrtf(red[0] / 1024.0f + EPS); __syncthreads();
    if (tid < 8) { const int col = dbg_hash(blockIdx.x * 8 + tid + 77) % D; float gate = mixb[2048 + col], sh = ffnb[col], scl = ffnb[1024 + col];
        for (int k = 0; k < D; ++k) { const float cv = c[b * 1024 + k], sv = cv / (1.0f + expf(-cv)); gate += sv * mixw[(size_t)k * 3072 + 2048 + col]; sh += sv * ffnw[(size_t)k * 3072 + col]; scl += sv * ffnw[(size_t)k * 3072 + 1024 + col]; }
        const float xo = xin[r * D + col] + gate * (h2f(y[col]) * rs[0] * post_g[col]);
        dbg_acc(dbg, 29, out[r * D + col], xo);
        dbg_acc(dbg, 30, h2f(((const bf16_t*)(reg + R_HF))[r * D + col]), out[r * D + col] * rs[1] * fpre_g[col] * (1.0f + scl) + sh); }
}
__global__ void dbg_apply(unsigned char* ws, float* out, int n, int nchk) {
    const float* dbg = (const float*)(ws + 512 * 1024); float a = 0.f;
    for (int k = nchk - 1; k >= 0; --k) { if (k >= 34) continue; const float d = dbg[2 * k] / fmaxf(dbg[2 * k + 1], 1e-30f); const float tol = ((k >= 25 && k <= 27) || k >= 31) ? 2e-3f : DBG_TOL; if (d > tol || !(dbg[2 * k + 1] > 0.f)) a = 0.05f * (float)(k + 1); }
    for (int i = blockIdx.x * blockDim.x + threadIdx.x; i < n; i += gridDim.x * blockDim.x) out[i] *= (1.0f + a);
}
#endif

#define OUT_H(out, hb)   ((bf16_t*)((unsigned char*)(out) + (size_t)(hb) * 64 * MiB))
#define OUT_X16(out, hb) ((bf16_t*)((unsigned char*)(out) + (size_t)(hb) * 64 * MiB + (size_t)32 * MiB))
constexpr size_t R_XLAST = R_FFN_END;
static_assert(R_XLAST + (size_t)MH * D * 2 <= (R_MIX_END > R_FFN_END ? R_MIX_END : R_FFN_END), "last layer's x' fits inside the region");
static_assert(IDX_SPLIT == 0, "the h low part is not produced any more");
constexpr size_t R2_ACT = 0;
constexpr size_t R2_Y2 = R2_ACT + (size_t)2 * MH * DFF * 2;
constexpr size_t R2_EDGE = R2_Y2 + (size_t)2 * MH * D * 2;
static_assert(R2_EDGE + (size_t)128 * 22 * 1024 * 2 <= (R_MIX_END > R_FFN_END ? R_MIX_END : R_FFN_END), "batched FFN buffers fit inside the region");
constexpr int NPH = 2 + 8 * 12;
struct Params { const float* in[29]; float* out; unsigned char* ws; int ph_lo, ph_hi; };
static_assert(sizeof(Params) == 31 * 8 + 8, "Params has no padding");

typedef const Params __attribute__((address_space(4))) * KParams;
#define PHASE_ARGS() KParams Q = KP; asm volatile("" : "+s"(Q)); unsigned char* ws = Q->ws; OPAQUE_GPTR(ws); unsigned char* reg = ws + WS_REG; float* mod = (float*)(ws + WS_MOD); float* out = Q->out; const float* x_in = Q->in[0]; \
    (void)reg; (void)mod; (void)out; (void)x_in

__global__ void __launch_bounds__(512, 2) trunk_fwd(Params P) {
    extern __shared__ __attribute__((aligned(16))) unsigned char lds_raw[];
    Ctx X; X.lds = (LAS unsigned char*)lds_raw; X.tid = threadIdx.x; X.lane = X.tid & 63; X.wave = __builtin_amdgcn_readfirstlane(X.tid >> 6);
    X.G = gridDim.x; { const int bx = blockIdx.x; X.vcu = (X.G % 8 == 0) ? (bx % 8) * (X.G / 8) + bx / 8 : bx; }
    KParams KP = (KParams)__builtin_amdgcn_kernarg_segment_ptr();
    const int lo = P.ph_lo, hi = P.ph_hi;
#if MK_ONE_LAUNCH
    volatile LAS unsigned* MISC = (volatile LAS unsigned*)(X.lds + MISC_OFF);
    if (X.tid < 64) MISC[X.tid] = 0u;
    __syncthreads();
    XcdBarrier bar = xcd_barrier_post((unsigned*)(P.ws + WS_CTL) + CW_BAR, MISC + 8);
#define SEAM(ph) do { if ((ph) + 1 < hi) xcd_barrier(bar); } while (0)
#else
#define SEAM(ph) do { } while (0)
#endif
#define IN(ph) ((ph) >= lo && (ph) < hi)

    if (IN(0)) {
        { PHASE_ARGS(); if (PHSEL(0)) phase_adaln(X, Q->in[1], Q->in[2], Q->in[3], Q->in[21], Q->in[22], mod); }
        __syncthreads();
        { PHASE_ARGS(); if (PHSEL(17)) phase_convert(X, ws, Q->in[6], Q->in[15], Q->in[19], Q->in[20], Q->in[25], Q->in[28]); }
        __syncthreads();
        { PHASE_ARGS(); if (PHSEL(18)) phase_s5pre(X, ws, Q->in[7], Q->in[8], Q->in[9], Q->in[10], Q->in[11], Q->in[12], Q->in[13]); }
        SEAM(0);
    }
    if (PHSEL(1) && IN(1)) { { PHASE_ARGS(); phase_t1(X, x_in, 0, 0, Q->in[4], mod, OUT_H(out, 0), nullptr); } { PHASE_ARGS(); phase_t1(X, x_in, 1, 0, Q->in[4], mod, OUT_H(out, 1), nullptr); } SEAM(1); }

    for (int it = 0; it < 8; ++it) {
        const int l = it >> 1, hb = it & 1, pb = 2 + it * 12;
        if (pb >= hi || pb + 12 <= lo) continue;
        if (PHSEL(2) && IN(pb + 0)) { PHASE_ARGS();
            pg8::Gemm g{(const bf16_t*)OUT_H(out, hb), (const bf16_t*)(ws + WS_WIN), D, D, D};
            EpiProj E{reg};
#if IDX_SPLIT
            pg8::SchedProj S{X.G, (int)blockIdx.x, (size_t)(R_HLO - R_H), (size_t)(WS_WINLO - WS_WIN)};
#else
            pg8::SchedGrid S; S.init(MH / 256, NPROJ / 256, X.G, (int)blockIdx.x, (size_t)256 * D * 2, (size_t)256 * D * 2);
#endif
            for (int rp = 0; rp < NREP(2); ++rp) pg8::gemm_phase(X.lds, g, S, E);
            SEAM(pb + 0);
        }
        if (IN(pb + 1)) {
            if (PHSEL(3)) { PHASE_ARGS(); pg8::Gemm g{(const bf16_t*)(reg + R_S5A), (const bf16_t*)(ws + WS_S5BS), S5K, 512, 512};
              pg8::SchedS5 S{X.G, (int)blockIdx.x, 1}; EpiS5State E{(float*)(reg + R_S5SC)};
              for (int rp = 0; rp < NREP(3); ++rp) pg8::gemm_phase(X.lds, g, S, E); }
            __syncthreads();
            if (PHSEL(4)) { PHASE_ARGS(); for (int rp = 0; rp < NREP(4); ++rp) for (int u = X.vcu; u < 4 * 64; u += X.G) gla_c1(X, reg, Q->in[16] + (size_t)l * 16 * 256, Q->in[17] + (size_t)l * 256, u >> 6, u & 63); }
            __syncthreads();
            if (PHSEL(5)) { PHASE_ARGS();
                for (int rp = 0; rp < NREP(5); ++rp) { LAS int* slot = (LAS int*)(X.lds + DSA_SEL_OFF + 400);
                    const int base = (512 + X.G) * (it * NREP(5) + rp);
                    __syncthreads(); if (X.tid == 0) slot[0] = (int)atomicAdd((unsigned*)(ws + WS_CTL) + CW_DSAQ, 1u); __syncthreads(); int k = slot[0] - base;
                    while (k < 512) k = dsa_mask_unit(X, reg, k & 3, 127 - (k >> 2)) - base; } }
            SEAM(pb + 1);
        }
        if (IN(pb + 2)) {
            if (PHSEL(6)) { PHASE_ARGS(); for (int rp = 0; rp < NREP(6); ++rp) phase_scans(X, reg, Q->in[7] + (size_t)l * 2048, Q->in[8] + (size_t)l * 2048, Q->in[9] + (size_t)l * 32); }
            __syncthreads();
            if (PHSEL(5)) { PHASE_ARGS(); for (int rp = 0; rp < NREP(20); ++rp) for (int u = X.vcu; u < 4 * 8 * 8; u += X.G) { const int bl = u >> 6, hh = (u >> 3) & 7, j = u & 7; dsa_attn_unit(X, reg, bl, hh, 15 - j); dsa_attn_unit(X, reg, bl, hh, j); } }
            SEAM(pb + 2);
        }
        if (IN(pb + 3)) {
            if (PHSEL(7)) { PHASE_ARGS(); pg8::Gemm g{(const bf16_t*)(reg + R_S5A), (const bf16_t*)(ws + WS_S5BO), S5K, S5K, S5K};
              pg8::SchedS5 S{X.G, (int)blockIdx.x, 2}; EpiS5Out E{(const bf16_t*)(reg + R_S5A), Q->in[14] + (size_t)l * 512, (bf16_t*)(reg + R_GACT)};
              for (int rp = 0; rp < NREP(7); ++rp) pg8::gemm_phase(X.lds, g, S, E); }
            __syncthreads();
            if (PHSEL(8)) { PHASE_ARGS();
                unsigned* qc = (unsigned*)(ws + WS_CTL) + CW_C3Q; LAS int* slot = (LAS int*)X.lds; const int base = (256 + X.G) * it;
                __syncthreads(); if (X.tid == 0) slot[0] = (int)atomicAdd(qc, 1u); __syncthreads(); int k = slot[0] - base;
                while (k < 256) { int kn = 0; if (X.tid == 0) kn = (int)atomicAdd(qc, 1u);
                    gla_c3(X, reg, Q->in[18] + (size_t)l * 512, k >> 6, k & 63);
                    __syncthreads(); if (X.tid == 0) slot[0] = kn; __syncthreads(); k = slot[0] - base; } }
            SEAM(pb + 3);
        }
        if (PHSEL(9) && IN(pb + 4)) { PHASE_ARGS();
            pg8::Gemm g{(const bf16_t*)(reg + R_GACT), (const bf16_t*)(ws + WS_WGLU), 512, 512, 512};
            pg8::SchedGrid S; S.init(MH / 256, 4, X.G, (int)blockIdx.x, (size_t)256 * 512 * 2, (size_t)256 * 512 * 2);
            EpiGlu E{(bf16_t*)(reg + R_YS) + (size_t)MH * 512};
            for (int rp = 0; rp < NREP(9); ++rp) pg8::gemm_phase(X.lds, g, S, E);
            SEAM(pb + 4);
        }
        if (PHSEL(10) && IN(pb + 5)) { PHASE_ARGS();
            pg8::Gemm g{(const bf16_t*)(reg + R_YS), (const bf16_t*)(ws + WS_WBR), 512, 512, 512};
            pg8::SchedMerge S; S.S.init(MH / 256, 4, X.G, (int)blockIdx.x, (size_t)256 * 512 * 2, (size_t)256 * 512 * 2); S.abr = (size_t)MH * 512 * 2; S.bbr = (size_t)1024 * 512 * 2;
            EpiMerge E{(const bf16_t*)(reg + R_GATES), (bf16_t*)(reg + R_H)};
            for (int rp = 0; rp < NREP(10); ++rp) pg8::gemm_phase(X.lds, g, S, E);
            SEAM(pb + 5);
        }
        if (PHSEL(11) && IN(pb + 6)) { PHASE_ARGS();
            pg8::Gemm g{(const bf16_t*)(reg + R_H), (const bf16_t*)(ws + WS_WOUT), D, D, D};
            pg8::SchedGrid S; S.init(MH / 256, 4, X.G, (int)blockIdx.x, (size_t)256 * D * 2, (size_t)256 * D * 2);
            EpiPlain E{(bf16_t*)(reg + R_Y), D};
            for (int rp = 0; rp < NREP(11); ++rp) pg8::gemm_phase(X.lds, g, S, E);
            SEAM(pb + 6);
        }
        if (PHSEL(12) && IN(pb + 7)) { PHASE_ARGS(); phase_t2(X, (l == 0) ? x_in : nullptr, OUT_X16(out, hb), (l == 3) ? (bf16_t*)(reg + R_XLAST) : OUT_X16(out, hb), hb, l, (const bf16_t*)(reg + R_Y), Q->in[5], Q->in[23], mod,
                                                              (l == 3) ? (bf16_t*)(reg + R_HF) : OUT_H(out, hb)); SEAM(pb + 7); }
        if (l == 3) {
        if (PHSEL(13) && IN(pb + 8)) { PHASE_ARGS();
            pg8::Gemm g{(const bf16_t*)(reg + R_HF), (const bf16_t*)(ws + WS_WUP), D, D, D};
            pg8::SchedGrid S; S.init(MH / 256, DUP / 256, X.G, (int)blockIdx.x, (size_t)256 * D * 2, (size_t)256 * D * 2);
            EpiUpConv E{Q->in[26] + (size_t)l * 3 * DUP, Q->in[27] + (size_t)l * DUP, (bf16_t*)(reg + R_ACT), (bf16_t*)(reg + R_U), (LAS unsigned*)(X.lds + 8 * pg8::HTB)};
            for (int rp = 0; rp < NREP(13); ++rp) pg8::gemm_phase(X.lds, g, S, E);
            SEAM(pb + 8);
        }
        if (PHSEL(15) && IN(pb + 10)) { PHASE_ARGS();
            pg8::Gemm g{(const bf16_t*)(reg + R_ACT), (const bf16_t*)(ws + WS_WDN), DFF, DFF, DFF};
            pg8::SchedGrid S; S.init(MH / 256, 4, X.G, (int)blockIdx.x, (size_t)256 * DFF * 2, (size_t)256 * DFF * 2);
            { pg8::Unit u0; for (int i = 0; S.next(i, u0); ++i) upfix_panel(X, (const bf16_t*)(reg + R_U), Q->in[26] + (size_t)l * 3 * DUP, Q->in[27] + (size_t)l * DUP, (bf16_t*)(reg + R_ACT), u0.pm); }
            asm volatile("s_waitcnt vmcnt(0)" ::: "memory"); __syncthreads();
            EpiPlain E{(bf16_t*)(reg + R_Y2), D};
            for (int rp = 0; rp < NREP(15); ++rp) pg8::gemm_phase(X.lds, g, S, E);
            SEAM(pb + 10);
        }
        if (PHSEL(16) && IN(pb + 11)) {
            { PHASE_ARGS(); phase_t4(X, (const bf16_t*)(reg + R_XLAST), OUT_X16(out, hb), out, OUT_H(out, hb), hb, l, (const bf16_t*)(reg + R_Y2), Q->in[24], Q->in[4], mod); }
            SEAM(pb + 11);
        }
        } else if (hb == 1) {
        if (PHSEL(13) && IN(pb + 8)) { PHASE_ARGS();
            pg8::Gemm g{(const bf16_t*)OUT_H(out, 0), (const bf16_t*)(ws + WS_WUP), D, D, D};
            pg8::SchedGrid S; S.init(2 * MH / 256, DUP / 256, X.G, (int)blockIdx.x, (size_t)256 * D * 2, (size_t)256 * D * 2); S.nMh = MH / 256; S.ahalf = (size_t)64 * MiB;
            EpiUpConv E{Q->in[26] + (size_t)l * 3 * DUP, Q->in[27] + (size_t)l * DUP, (bf16_t*)(reg + R2_ACT), (bf16_t*)(reg + R2_EDGE), (LAS unsigned*)(X.lds + 8 * pg8::HTB)};
            pg8::gemm_phase(X.lds, g, S, E);
            SEAM(pb + 8);
        }
        if (PHSEL(15) && IN(pb + 10)) { PHASE_ARGS();
            pg8::Gemm g{(const bf16_t*)(reg + R2_ACT), (const bf16_t*)(ws + WS_WDN), DFF, DFF, DFF};
            pg8::SchedGrid S; S.init(2 * MH / 256, 4, X.G, (int)blockIdx.x, (size_t)256 * DFF * 2, (size_t)256 * DFF * 2);
            { pg8::Unit u0; for (int i = 0; S.next(i, u0); ++i) upfix_panel(X, (const bf16_t*)(reg + R2_EDGE), Q->in[26] + (size_t)l * 3 * DUP, Q->in[27] + (size_t)l * DUP, (bf16_t*)(reg + R2_ACT), u0.pm); }
            asm volatile("s_waitcnt vmcnt(0)" ::: "memory"); __syncthreads();
            EpiPlain E{(bf16_t*)(reg + R2_Y2), D};
            pg8::gemm_phase(X.lds, g, S, E);
            SEAM(pb + 10);
        }
        if (PHSEL(16) && IN(pb + 11)) {
            { PHASE_ARGS(); phase_t4(X, (const bf16_t*)OUT_X16(out, 0), OUT_X16(out, 0), nullptr, OUT_H(out, 0), 0, l, (const bf16_t*)(reg + R2_Y2), Q->in[24], Q->in[4], mod); }
            { PHASE_ARGS(); phase_t4(X, (const bf16_t*)OUT_X16(out, 1), OUT_X16(out, 1), nullptr, OUT_H(out, 1), 1, l, (const bf16_t*)(reg + R2_Y2) + (size_t)MH * D, Q->in[24], Q->in[4], mod); }
            { const int l2 = l + 1;
                __syncthreads();
                { PHASE_ARGS(); for (int rp = 0; rp < NREP(17); ++rp) phase_convert(X, ws, Q->in[6] + (size_t)l2 * D * D_IN, Q->in[15] + (size_t)l2 * 512 * 1024, Q->in[19] + (size_t)l2 * 3 * 512 * 1024, Q->in[20] + (size_t)l2 * D * D,
                              Q->in[25] + (size_t)l2 * D * DUP, Q->in[28] + (size_t)l2 * DFF * D); }
                __syncthreads();
                { PHASE_ARGS(); for (int rp = 0; rp < NREP(18); ++rp) phase_s5pre(X, ws, Q->in[7] + (size_t)l2 * 2048, Q->in[8] + (size_t)l2 * 2048, Q->in[9] + (size_t)l2 * 32, Q->in[10] + (size_t)l2 * 32768, Q->in[11] + (size_t)l2 * 32768,
                            Q->in[12] + (size_t)l2 * 32768, Q->in[13] + (size_t)l2 * 32768); }
            }
            SEAM(pb + 11);
        }
        }
    }
#undef IN
#undef SEAM
}

extern "C" void kernel_launch(void* const* d_in, const int* in_sizes, int n_in, void* d_out, int out_size, void* d_ws, size_t ws_size, hipStream_t stream) {
    static int grid = 0;
    if (grid == 0) {
        if (n_in != 29 || out_size != BATCH * T * D || ws_size < WS_END) { fprintf(stderr, "kernel_launch: unexpected shapes or workspace (%d inputs, out %d, ws %zu < %zu)\n", n_in, out_size, ws_size, (size_t)WS_END); grid = -1; return; }
        int dev = 0, cus = 0;
        if (hipGetDevice(&dev) != hipSuccess || hipDeviceGetAttribute(&cus, hipDeviceAttributeMultiprocessorCount, dev) != hipSuccess) { grid = -1; return; }
        if (hipFuncSetAttribute((const void*)trunk_fwd, hipFuncAttributeMaxDynamicSharedMemorySize, LDS_BYTES) != hipSuccess) { fprintf(stderr, "kernel_launch: hipFuncSetAttribute failed\n"); grid = -1; return; }
        int per_cu = 0;
        if (hipOccupancyMaxActiveBlocksPerMultiprocessor(&per_cu, (const void*)trunk_fwd, 512, LDS_BYTES) != hipSuccess || per_cu < 1) fprintf(stderr, "kernel_launch: occupancy query says %d\n", per_cu);
        (void)hipGetLastError();
        grid = cus;
    }
    if (grid < 0) return;
    (void)in_sizes;
    (void)hipMemsetAsync((char*)d_ws + WS_CTL, 0, CTL_BYTES, stream);
    Params p{};
    for (int i = 0; i < 29; ++i) p.in[i] = (const float*)d_in[i];
    p.out = (float*)d_out; p.ws = (unsigned char*)d_ws;
#if MK_ONE_LAUNCH
    p.ph_lo = 0; p.ph_hi = NPH;
    hipLaunchKernelGGL(trunk_fwd, dim3(grid), dim3(512), LDS_BYTES, stream, p);
#else
    for (int ph = 0; ph < NPH; ++ph) { p.ph_lo = ph; p.ph_hi = ph + 1; hipLaunchKernelGGL(trunk_fwd, dim3(grid), dim3(512), LDS_BYTES, stream, p);
#ifdef DBG_CHECKS
        unsigned char* ws = (unsigned char*)d_ws; const int pb7 = 2 + 7 * 12, pb6 = 2 + 6 * 12;
        if (ph == pb6 + 11) hipLaunchKernelGGL(dbg_chk_w, dim3(64), dim3(256), 0, stream, ws, p.in[6] + (size_t)3 * D * D_IN, p.in[15] + (size_t)3 * 512 * 1024, p.in[19] + (size_t)3 * 3 * 512 * 1024, p.in[20] + (size_t)3 * D * D, p.in[25] + (size_t)3 * D * DUP, p.in[28] + (size_t)3 * DFF * D);
        if (ph == pb7 + 0) hipLaunchKernelGGL(dbg_chk_proj, dim3(16), dim3(256), 0, stream, ws);
        if (ph == pb7 + 1) hipLaunchKernelGGL(dbg_chk_dsa, dim3(24), dim3(256), 0, stream, ws);
        if (ph == pb7 + 3) { hipLaunchKernelGGL(dbg_chk_gla, dim3(8), dim3(128), 0, stream, ws, p.in[16] + (size_t)3 * 16 * 256, p.in[17] + (size_t)3 * 256, p.in[18] + (size_t)3 * 512);
            hipLaunchKernelGGL(dbg_chk_s5, dim3(8), dim3(64), 0, stream, ws, p.in[7] + (size_t)3 * 2048, p.in[8] + (size_t)3 * 2048, p.in[9] + (size_t)3 * 32, p.in[10] + (size_t)3 * 32768, p.in[11] + (size_t)3 * 32768, p.in[12] + (size_t)3 * 32768, p.in[13] + (size_t)3 * 32768, p.in[14] + (size_t)3 * 512); }
        if (ph == pb6 + 11) hipLaunchKernelGGL(dbg_chk_t1, dim3(64), dim3(256), 0, stream, ws, (const float*)d_out, p.in[1], p.in[2] + (size_t)3 * 1024 * 3072, p.in[3] + (size_t)3 * 3072, p.in[4] + (size_t)3 * D);
        if (ph == 2 + 7) hipLaunchKernelGGL(dbg_chk_t2, dim3(64), dim3(256), 0, stream, ws, p.in[0], (const float*)d_out, p.in[1], p.in[2], p.in[3], p.in[21], p.in[22], p.in[5], p.in[23]);
        if (ph == pb7 + 4) hipLaunchKernelGGL(dbg_chk_glu, dim3(16), dim3(256), 0, stream, ws);
        if (ph == pb7 + 5) hipLaunchKernelGGL(dbg_chk_merge, dim3(16), dim3(256), 0, stream, ws);
        if (ph == pb7 + 6) hipLaunchKernelGGL(dbg_chk_gemm, dim3(16), dim3(256), 0, stream, ws, 21, R_H, D, WS_WOUT, D, R_Y, D, D);
        if (ph == pb7 + 8) hipLaunchKernelGGL(dbg_chk_gemm, dim3(16), dim3(256), 0, stream, ws, 22, R_HF, D, WS_WUP, D, R_U, DUP, DUP);
        if (ph == pb7 + 9) hipLaunchKernelGGL(dbg_chk_act, dim3(16), dim3(256), 0, stream, ws, p.in[26] + (size_t)3 * 3 * DUP, p.in[27] + (size_t)3 * DUP);
        if (ph == pb7 + 10) hipLaunchKernelGGL(dbg_chk_gemm, dim3(16), dim3(256), 0, stream, ws, 23, R_ACT, DFF, WS_WDN, DFF, R_Y2, D, D);
        if (ph == NPH - 1) hipLaunchKernelGGL(dbg_apply, dim3(1024), dim3(256), 0, stream, ws, (float*)d_out, BATCH * T * D, 34);
#endif
    }
#endif
}
```
